# Optimizing an MI355X kernel written in HIP

```python
import jax
import jax.numpy as jnp
from jax import lax
import numpy as np

D_MODEL = 2048
BATCH = 2
SEQ = 16384
DEPTH = 2

HEAD_DIM = 64
BRANCH_DIM = D_MODEL // 2
RWKV_HEADS = BRANCH_DIM // HEAD_DIM
DECAY_LORA = 96
ICLR_LORA = 96
GATE_LORA = 256
RWKV_COLS = 3 * BRANCH_DIM + DECAY_LORA + ICLR_LORA + GATE_LORA
POOL_WINDOWS = (2, 4, 8, 16)
POOL_GROUPS = len(POOL_WINDOWS)
POOL_GROUP_DIM = BRANCH_DIM // POOL_GROUPS
ATTN_Q_HEADS = BRANCH_DIM // HEAD_DIM
ATTN_KV_HEADS = 4
ATTN_GROUP = ATTN_Q_HEADS // ATTN_KV_HEADS
ATTN_KV_DIM = ATTN_KV_HEADS * HEAD_DIM
WINDOW = 128
ROPE_THETA = 10000.0
N_BRANCHES = 3
IN_COLS = RWKV_COLS + BRANCH_DIM + BRANCH_DIM + 2 * ATTN_KV_DIM + N_BRANCHES * D_MODEL
N_GROUPS = 4
EXPERTS_PER_GROUP = 8
N_EXPERTS = N_GROUPS * EXPERTS_PER_GROUP
TOP_K = 2
EXPERT_FF = 512
EXPERT_BLOCK = 128
NORM_EPS = 1e-6
GN_EPS = 64e-5

kernel_name = 'hybrid_rwkv7_pool_swa_hiermoe'


def rms_norm(x, g):
    xf = x.astype(jnp.float32)
    y = xf * lax.rsqrt(jnp.mean(xf * xf, axis=-1, keepdims=True) + NORM_EPS)
    return (y * g.astype(jnp.float32)).astype(x.dtype)


def token_shift(z, mu):
    z_prev = jnp.pad(z, ((0, 0), (1, 0), (0, 0)))[:, :-1]
    return z + (z_prev - z) * mu


def rwkv7_time_mix(z, w0, w_up, a0, a_up, g_up, k_k, k_a, r_k, ln_g, ln_b):
    B, S, _ = z.shape
    H, N, c = RWKV_HEADS, HEAD_DIM, BRANCH_DIM
    r, k, v, wd, ad, gd = jnp.split(
        z, [c, 2 * c, 3 * c, 3 * c + DECAY_LORA, 3 * c + DECAY_LORA + ICLR_LORA], axis=-1)
    w_log = -jax.nn.softplus(-(w0 + jnp.tanh(wd) @ w_up)) - 0.5
    decay = jnp.exp(-jnp.exp(w_log))
    a = jax.nn.sigmoid(a0 + ad @ a_up)
    g = jax.nn.sigmoid(gd) @ g_up
    kk = (k * k_k).reshape(B, S, H, N)
    kk = kk * lax.rsqrt(jnp.maximum(jnp.sum(kk * kk, axis=-1, keepdims=True), 1e-24))
    k = k * (1.0 + (a - 1.0) * k_a)
    heads = lambda t: t.reshape(B, S, H, N)
    r, k, v, decay, a = heads(r), heads(k), heads(v), heads(decay), heads(a)
    xs = tuple(jnp.moveaxis(t, 1, 0) for t in (r, decay, k, v, kk, a))

    def step(state, inp):
        r_t, w_t, k_t, v_t, kk_t, a_t = inp
        sa = jnp.einsum('bhvk,bhk->bhv', state, -kk_t)
        state = (state * w_t[:, :, None, :]
                 + sa[..., None] * (kk_t * a_t)[:, :, None, :]
                 + v_t[..., None] * k_t[:, :, None, :])
        return state, jnp.einsum('bhvk,bhk->bhv', state, r_t)

    state0 = jnp.zeros((B, H, N, N), jnp.float32)
    _, y = lax.scan(step, state0, xs)
    y = jnp.moveaxis(y, 0, 1)
    mean = jnp.mean(y, axis=-1, keepdims=True)
    var = jnp.mean(jnp.square(y - mean), axis=-1, keepdims=True)
    y = ((y - mean) * lax.rsqrt(var + GN_EPS)).reshape(B, S, c) * ln_g + ln_b
    bonus = jnp.sum(r * k * r_k, axis=-1, keepdims=True) * v
    return (y + bonus.reshape(B, S, c)) * g


def multiscale_pool(u, pool_w, pool_scale):
    B, S, _ = u.shape
    uf = u.astype(jnp.float32)
    cs = jnp.cumsum(uf, axis=1)
    t = jnp.arange(S)
    outs = []
    for gi, m in enumerate(POOL_WINDOWS):
        sl = slice(gi * POOL_GROUP_DIM, (gi + 1) * POOL_GROUP_DIM)
        c = cs[..., sl]
        lag = jnp.pad(c, ((0, 0), (m, 0), (0, 0)))[:, :S]
        count = jnp.minimum(t + 1, m).astype(jnp.float32)[None, :, None]
        pooled = (c - lag) / count - uf[..., sl]
        outs.append(pooled @ pool_w[gi])
    return jnp.concatenate(outs, axis=-1) * pool_scale


def rope(x, positions):
    half = HEAD_DIM // 2
    inv_freq = ROPE_THETA ** (-jnp.arange(half, dtype=jnp.float32) / half)
    ang = positions.astype(jnp.float32)[..., None] * inv_freq
    cos = jnp.cos(ang)[:, :, None, :]
    sin = jnp.sin(ang)[:, :, None, :]
    xf = x.astype(jnp.float32)
    x1, x2 = xf[..., :half], xf[..., half:]
    return jnp.concatenate([x1 * cos - x2 * sin, x2 * cos + x1 * sin], axis=-1).astype(x.dtype)


def sliding_window_attention(q, k, v, sinks):
    B, S, _, _ = q.shape
    nb = S // WINDOW
    qb = q.reshape(B, nb, WINDOW, ATTN_KV_HEADS, ATTN_GROUP, HEAD_DIM)

    def band(t):
        t = t.reshape(B, nb, WINDOW, ATTN_KV_HEADS, HEAD_DIM)
        prev = jnp.pad(t, ((0, 0), (1, 0), (0, 0), (0, 0), (0, 0)))[:, :-1]
        return jnp.concatenate([prev, t], axis=2)

    kb, vb = band(k), band(v)
    s = jnp.einsum('bnqhgd,bnkhd->bnhgqk', qb, kb).astype(jnp.float32) * (HEAD_DIM ** -0.5)
    qi = jnp.arange(WINDOW)[:, None]
    kj = jnp.arange(2 * WINDOW)[None, :]
    rel = kj - qi
    in_window = (rel >= 1) & (rel <= WINDOW)
    valid = in_window[None] & ((jnp.arange(nb)[:, None, None] > 0) | (kj >= WINDOW)[None])
    s = jnp.where(valid[None, :, None, None], s, -jnp.inf)
    sink = sinks.astype(jnp.float32).reshape(ATTN_KV_HEADS, ATTN_GROUP)[None, None, :, :, None, None]
    m = jnp.maximum(jnp.max(s, axis=-1, keepdims=True), sink)
    e = jnp.exp(s - m)
    p = e / (jnp.sum(e, axis=-1, keepdims=True) + jnp.exp(sink - m))
    o = jnp.einsum('bnhgqk,bnkhd->bnqhgd', p.astype(v.dtype), vb)
    return o.reshape(B, S, ATTN_Q_HEADS * HEAD_DIM)


def hier_moe(h, w_grp, b_grp, w_exp, b_exp, w1, w3, w2):
    B, S, D = h.shape
    n = B * S
    hf = h.reshape(n, D)
    grp_logits = (hf @ w_grp).astype(jnp.float32) + b_grp.astype(jnp.float32)
    grp_prob = jax.nn.softmax(grp_logits, axis=-1)
    grp = jnp.argmax(grp_logits, axis=-1).astype(jnp.int32)
    p_grp = jnp.take_along_axis(grp_prob, grp[:, None], axis=1)
    exp_logits = ((hf @ w_exp).astype(jnp.float32) + b_exp.astype(jnp.float32)).reshape(
        n, N_GROUPS, EXPERTS_PER_GROUP)
    in_grp = jnp.take_along_axis(exp_logits, grp[:, None, None], axis=1)[:, 0]
    top_p, top_i = lax.top_k(jax.nn.softmax(in_grp, axis=-1), TOP_K)
    gate = p_grp * top_p / jnp.sum(top_p, axis=-1, keepdims=True)
    expert = (grp[:, None] * EXPERTS_PER_GROUP + top_i).reshape(-1).astype(jnp.int32)
    token = jnp.repeat(jnp.arange(n, dtype=jnp.int32), TOP_K)
    order = jnp.argsort(expert)
    e_sorted = expert[order]
    counts = jnp.zeros((N_EXPERTS,), jnp.int32).at[expert].add(1)
    padded = (counts + EXPERT_BLOCK - 1) // EXPERT_BLOCK * EXPERT_BLOCK
    starts = jnp.cumsum(counts) - counts
    pends = jnp.cumsum(padded)
    pstarts = pends - padded
    dest_sorted = pstarts[e_sorted] + jnp.arange(n * TOP_K, dtype=jnp.int32) - starts[e_sorted]
    n_rows = -(-(n * TOP_K) // EXPERT_BLOCK) * EXPERT_BLOCK + N_EXPERTS * EXPERT_BLOCK
    n_blocks = n_rows // EXPERT_BLOCK
    row_token = jnp.full((n_rows,), n, jnp.int32).at[dest_sorted].set(token[order])
    h_pad = jnp.concatenate([hf, jnp.zeros((1, D), hf.dtype)], axis=0)
    xg = h_pad[row_token].reshape(n_blocks, EXPERT_BLOCK, D)
    block_start = jnp.arange(n_blocks, dtype=jnp.int32) * EXPERT_BLOCK
    block_expert = jnp.minimum(jnp.searchsorted(pends, block_start, side='right'), N_EXPERTS - 1)

    def expert_block(args):
        xb, e = args
        return (jax.nn.silu(xb @ w1[e]) * (xb @ w3[e])) @ w2[e]

    yg = lax.map(expert_block, (xg, block_expert)).reshape(n_rows, D)
    dest = jnp.zeros((n * TOP_K,), jnp.int32).at[order].set(dest_sorted).reshape(n, TOP_K)
    y = jnp.einsum('nk,nkd->nd', gate.astype(h.dtype), yg[dest])
    return y.reshape(B, S, D)


def setup_inputs(seed: int = 0) -> dict:
    key = jax.random.key(seed)
    ks = jax.random.split(key, 32)
    L, D, c = DEPTH, D_MODEL, BRANCH_DIM
    nrm = lambda k, shape, scale: scale * jax.random.normal(k, shape, jnp.float32)
    return {
        'x': nrm(ks[0], (BATCH, SEQ, D), 1.0),
        'positions': jnp.broadcast_to(jnp.arange(SEQ, dtype=jnp.int32)[None, :], (BATCH, SEQ)),
        'attn_norm': 1.0 + nrm(ks[1], (L, D), 0.05),
        'w_in': nrm(ks[2], (L, D, IN_COLS), D ** -0.5),
        'tmix_mu': jax.random.uniform(ks[3], (L, RWKV_COLS), jnp.float32),
        'rwkv_w0': -2.0 + nrm(ks[4], (L, c), 1.0),
        'rwkv_w_up': nrm(ks[5], (L, DECAY_LORA, c), DECAY_LORA ** -0.5),
        'rwkv_a0': nrm(ks[6], (L, c), 0.5),
        'rwkv_a_up': nrm(ks[7], (L, ICLR_LORA, c), ICLR_LORA ** -0.5),
        'rwkv_g_up': nrm(ks[8], (L, GATE_LORA, c), GATE_LORA ** -0.5),
        'rwkv_k_k': 0.85 + nrm(ks[9], (L, c), 0.05),
        'rwkv_k_a': 1.0 + nrm(ks[10], (L, c), 0.05),
        'rwkv_r_k': nrm(ks[11], (L, RWKV_HEADS, HEAD_DIM), 0.1),
        'rwkv_ln_g': 1.0 + nrm(ks[12], (L, c), 0.05),
        'rwkv_ln_b': nrm(ks[13], (L, c), 0.02),
        'pool_w': nrm(ks[14], (L, POOL_GROUPS, POOL_GROUP_DIM, POOL_GROUP_DIM), POOL_GROUP_DIM ** -0.5),
        'pool_scale': 1.0 + nrm(ks[15], (L, c), 0.1),
        'q_norm': 1.0 + nrm(ks[16], (L, HEAD_DIM), 0.05),
        'k_norm': 1.0 + nrm(ks[17], (L, HEAD_DIM), 0.05),
        'attn_sinks': nrm(ks[18], (L, ATTN_Q_HEADS), 1.0),
        'w_branch': nrm(ks[19], (L, N_BRANCHES, c, D), c ** -0.5),
        'w_out': nrm(ks[20], (L, D, D), D ** -0.5),
        'ffn_norm': 1.0 + nrm(ks[21], (L, D), 0.05),
        'router_grp_w': nrm(ks[22], (L, D, N_GROUPS), D ** -0.5),
        'router_grp_b': nrm(ks[23], (L, N_GROUPS), 0.01),
        'router_exp_w': nrm(ks[24], (L, D, N_EXPERTS), D ** -0.5),
        'router_exp_b': nrm(ks[25], (L, N_EXPERTS), 0.01),
        'expert_w1': nrm(ks[26], (L, N_EXPERTS, D, EXPERT_FF), D ** -0.5),
        'expert_w3': nrm(ks[27], (L, N_EXPERTS, D, EXPERT_FF), D ** -0.5),
        'expert_w2': nrm(ks[28], (L, N_EXPERTS, EXPERT_FF, D), EXPERT_FF ** -0.5),
    }


def reference(x, positions, attn_norm, w_in, tmix_mu, rwkv_w0, rwkv_w_up, rwkv_a0, rwkv_a_up,
              rwkv_g_up, rwkv_k_k, rwkv_k_a, rwkv_r_k, rwkv_ln_g, rwkv_ln_b, pool_w, pool_scale,
              q_norm, k_norm, attn_sinks, w_branch, w_out, ffn_norm, router_grp_w, router_grp_b,
              router_exp_w, router_exp_b, expert_w1, expert_w3, expert_w2):
    B, S, _ = x.shape
    c = BRANCH_DIM
    splits = np.cumsum([RWKV_COLS, c, c, ATTN_KV_DIM, ATTN_KV_DIM]).tolist()
    for l in range(DEPTH):
        h = rms_norm(x, attn_norm[l])
        proj = h @ w_in[l]
        z, u, q, k, v, gate_logits = jnp.split(proj, splits, axis=-1)
        z = token_shift(z.astype(jnp.float32), tmix_mu[l])
        a_out = rwkv7_time_mix(z, rwkv_w0[l], rwkv_w_up[l], rwkv_a0[l], rwkv_a_up[l], rwkv_g_up[l],
                               rwkv_k_k[l], rwkv_k_a[l], rwkv_r_k[l], rwkv_ln_g[l], rwkv_ln_b[l])
        b_out = multiscale_pool(u, pool_w[l], pool_scale[l])
        q = rope(rms_norm(q.reshape(B, S, ATTN_Q_HEADS, HEAD_DIM), q_norm[l]), positions)
        k = rope(rms_norm(k.reshape(B, S, ATTN_KV_HEADS, HEAD_DIM), k_norm[l]), positions)
        v = v.reshape(B, S, ATTN_KV_HEADS, HEAD_DIM)
        c_out = sliding_window_attention(q, k, v, attn_sinks[l])
        gates = jax.nn.sigmoid(gate_logits.astype(jnp.float32).reshape(B, S, N_BRANCHES, D_MODEL))
        merged = (gates[:, :, 0] * (a_out.astype(x.dtype) @ w_branch[l, 0])
                  + gates[:, :, 1] * (b_out.astype(x.dtype) @ w_branch[l, 1])
                  + gates[:, :, 2] * (c_out @ w_branch[l, 2]))
        x = x + merged.astype(x.dtype) @ w_out[l]
        x = x + hier_moe(rms_norm(x, ffn_norm[l]), router_grp_w[l], router_grp_b[l], router_exp_w[l],
                         router_exp_b[l], expert_w1[l], expert_w3[l], expert_w2[l])
    return x
```

```cpp
#include <hip/hip_runtime.h>
#include <cstdio>
#include <cstdint>

#ifndef PROBE_MASK
#define PROBE_MASK 0
#endif
#define PROBE_REPS(k) (((PROBE_MASK >> (k)) & 1) ? 2 : 1)
#ifndef MK_ONE_LAUNCH
#define MK_ONE_LAUNCH 1
#endif

#define GAS __attribute__((address_space(1)))
#define LAS __attribute__((address_space(3)))
typedef unsigned short bf16;
typedef _Float16 f16;
typedef unsigned v4u __attribute__((ext_vector_type(4)));
typedef unsigned v2u __attribute__((ext_vector_type(2)));
typedef float f32x2 __attribute__((ext_vector_type(2)));
typedef float f32x4 __attribute__((ext_vector_type(4)));
typedef float f32x16 __attribute__((ext_vector_type(16)));
typedef short bf16x8 __attribute__((ext_vector_type(8)));
typedef short s16x4 __attribute__((ext_vector_type(4)));
typedef _Float16 f16x4 __attribute__((ext_vector_type(4)));
typedef _Float16 f16x8 __attribute__((ext_vector_type(8)));
typedef GAS unsigned gu32;
#define DI __device__ __forceinline__
#define RLX_AGENT __ATOMIC_RELAXED, __HIP_MEMORY_SCOPE_AGENT
#define LDS_WAIT() asm volatile("s_waitcnt lgkmcnt(0)" ::: "memory")
#define VM_WAIT() asm volatile("s_waitcnt vmcnt(0)" ::: "memory")

constexpr int NB = 2, SEQ = 16384, NT = NB * SEQ, D = 2048, C = 1024, NH = 16, HD = 64, DEPTH = 2;
constexpr int ZC = 3520, ZP = 3584;
constexpr int NPROJ = 6144;
constexpr int NGATE = 6144, INC = 12224, INP = 12288;
constexpr int NEXP = 32, FF = 512;
constexpr int NCHAIN = NB * NH;
constexpr int HM_ROWS = 73728;
constexpr float NORM_EPS = 1e-6f, GN_EPS = 64e-5f;

constexpr size_t MiB = 1u << 20;
constexpr size_t WS_CTL = 0, CTL_BYTES = 1 * MiB;
constexpr size_t WS_W = 1 * MiB;
constexpr size_t W_WIN = 0, W_LORA = 48 * MiB, W_POOL = W_LORA + 3 * 1024 * 256 * 2, W_BR = 50 * MiB, W_WO = 62 * MiB, W_RT = 70 * MiB;
constexpr size_t WS_H = 72 * MiB;
constexpr size_t WS_A2 = 200 * MiB;
constexpr size_t A2_Z = 0, A2_U = 224 * MiB, A2_Q = 288 * MiB, A2_K = 352 * MiB, A2_V = 368 * MiB;
constexpr size_t A2_G = 0, A2_BOUT = 64 * MiB, A2_COUT = 128 * MiB, A2_Y = 224 * MiB, A2_AOUT = 288 * MiB;
constexpr size_t A2_HM = 0, A2_Y2 = 72 * MiB;
constexpr size_t WS_A3 = 584 * MiB;
constexpr size_t PLANE = 64 * MiB;
enum { PL_R = 0, PL_W = 1, PL_K = 2, PL_V = 3, PL_KK = 4, PL_B = 5 };
constexpr size_t A3_W13 = 0, A3_W2 = 128 * MiB;
constexpr size_t WS_A4 = 968 * MiB;
constexpr size_t A4_LORA = 0, A4_POOL = 64 * MiB;
constexpr size_t WS_LOG = 1096 * MiB;
constexpr size_t WS_LIST = 1104 * MiB;
constexpr size_t WS_TG = 1108 * MiB;
constexpr size_t WS_FRAG = 1109 * MiB;
constexpr size_t FRAG_BUF = 80 * MiB, FRAG_V = 64 * MiB;
constexpr size_t WS_SFRAG = 968 * MiB;
constexpr size_t WS_BON = 1269 * MiB;
constexpr size_t WS_END = 1271 * MiB;
constexpr int CW_BAR = 4096;
constexpr int CW_SCAN = 32768, CW_SDONE = 4 * 8 * 32 * 64;
constexpr int CW_CNT = 16384;

constexpr int RING_BYTES = 131072;
constexpr int TBL_OFF = RING_BYTES;
constexpr int MISC_OFF = RING_BYTES + 16384;
constexpr int XTR_OFF = 151552;
constexpr int LDS_BYTES = 163840;
constexpr int NWAVES = 8;

DI unsigned f2bf(float f) { unsigned u = __builtin_bit_cast(unsigned, f); return (u + 0x7fffu + ((u >> 16) & 1u)) >> 16; }
DI float bflo(unsigned u) { return __builtin_bit_cast(float, u << 16); }
DI float bfhi(unsigned u) { return __builtin_bit_cast(float, u & 0xffff0000u); }
DI unsigned cvt_pk_bf16(float lo, float hi) { unsigned r; asm volatile("v_cvt_pk_bf16_f32 %0, %1, %2" : "=v"(r) : "v"(lo), "v"(hi)); return r; }
typedef __bf16 bf16x2_t __attribute__((ext_vector_type(2)));
DI unsigned cvt_pk_bf16_c(float lo, float hi) { const f32x2 v = {lo, hi}; return __builtin_bit_cast(unsigned, __builtin_convertvector(v, bf16x2_t)); }
DI unsigned pk2(float lo, float hi) { return cvt_pk_bf16_c(lo, hi); }
DI unsigned pkh2(float lo, float hi) { typedef _Float16 h2 __attribute__((ext_vector_type(2))); h2 v; v.x = (f16)lo; v.y = (f16)hi; return __builtin_bit_cast(unsigned, v); }
DI float hlo(unsigned u) { typedef _Float16 h2 __attribute__((ext_vector_type(2))); h2 v = __builtin_bit_cast(h2, u); return (float)v.x; }
DI float hhi(unsigned u) { typedef _Float16 h2 __attribute__((ext_vector_type(2))); h2 v = __builtin_bit_cast(h2, u); return (float)v.y; }
DI void unpack_bf8(v4u p, float (&o)[8]) { o[0] = bflo(p.x); o[1] = bfhi(p.x); o[2] = bflo(p.y); o[3] = bfhi(p.y); o[4] = bflo(p.z); o[5] = bfhi(p.z); o[6] = bflo(p.w); o[7] = bfhi(p.w); }
DI void unpack_h8(v4u p, float (&o)[8]) { o[0] = hlo(p.x); o[1] = hhi(p.x); o[2] = hlo(p.y); o[3] = hhi(p.y); o[4] = hlo(p.z); o[5] = hhi(p.z); o[6] = hlo(p.w); o[7] = hhi(p.w); }
DI v4u pack_bf8(const float (&o)[8]) { v4u w; w.x = pk2(o[0], o[1]); w.y = pk2(o[2], o[3]); w.z = pk2(o[4], o[5]); w.w = pk2(o[6], o[7]); return w; }
DI v4u pack_h8(const float (&o)[8]) { v4u w; w.x = pkh2(o[0], o[1]); w.y = pkh2(o[2], o[3]); w.z = pkh2(o[4], o[5]); w.w = pkh2(o[6], o[7]); return w; }
DI float sigmoidf_(float x) { return 1.0f / (1.0f + __expf(-x)); }
DI float rcpf_(float x) { return __builtin_amdgcn_rcpf(x); }
DI float sigmoid_r(float x) { return rcpf_(1.0f + __expf(-x)); }
template <int CTRL> DI float dpp_mov(float v) { return __builtin_bit_cast(float, __builtin_amdgcn_update_dpp(0, __builtin_bit_cast(int, v), CTRL, 0xf, 0xf, false)); }
DI float grp8_sum(float v) { v += dpp_mov<0xB1>(v); v += dpp_mov<0x4E>(v); v += dpp_mov<0x141>(v); return v; }
DI float grp32_sum(float v) { v = grp8_sum(v); v += dpp_mov<0x140>(v); v += __builtin_bit_cast(float, __builtin_amdgcn_ds_swizzle(__builtin_bit_cast(int, v), 0x401F)); return v; }
DI float wave_sum(float v) { v = grp32_sum(v); v += __shfl_xor(v, 32); return v; }

namespace pg {
constexpr int BM = 256, BK = 64, HALF = 128, HTB = HALF * BK * 2, STAGE_BYTES = 8 * HTB, NXCD = 8, WGM = 4;
DI int lds_byte(int r, int c) { const int st = (r >> 4) * 2 + (c >> 5), rr = r & 15, cc = c & 31, ob = rr * 64 + cc * 2; return st * 1024 + (ob ^ (((ob >> 9) & 1) << 5)); }
DI void stage_rc(int b, int& R, int& Cc) { const int st = b / 1024, sb = b % 1024, swz = sb ^ (((sb >> 9) & 1) << 5); R = (st >> 1) * 16 + swz / 64; Cc = (st & 1) * 32 + (swz % 64) / 2; }
DI int perm32(int rho) { const int n = rho >> 4, i = rho & 15; return 8 * (i >> 2) + 4 * n + (i & 3); }

struct Unit { const char* A; const char* B; int pm, pn, aux; };
DI const char* launder(const char* p) { asm volatile("" : "+s"(p)); return p; }

DI bool static_tile(long L, int nM, int nN, int& pm, int& pn) {
    const int nwg = nM * nN; if (L >= nwg) return false;
    int wgid = (int)L; { const int q = nwg / NXCD, r = nwg % NXCD, xcd = wgid % NXCD, off = wgid / NXCD; wgid = (xcd < r ? xcd * (q + 1) : r * (q + 1) + (xcd - r) * q) + off; }
    const int nig = WGM * nN, gid = wgid / nig, fm = gid * WGM, gsz = (nM - fm) < WGM ? (nM - fm) : WGM;
    pm = fm + ((wgid % nig) % gsz); pn = (wgid % nig) / gsz; return true;
}

template <class Epi, class Sched, bool GATHER>
DI void gemm_phase(LAS unsigned char* lds, const int lda, const int ldb, const int K, const Sched& S, const Epi& E) {
    int tid_ = threadIdx.x; asm volatile("" : "+v"(tid_));
    const int tid = tid_, wid = __builtin_amdgcn_readfirstlane(tid >> 6), lane = tid & 63, wr = wid >> 2, wc = wid & 3, fr = lane & 15, fq = lane >> 4;
    const int nt = K / BK;
    unsigned voffA[2][2], voffB[2]; int rowA[2], colA[2];
#pragma unroll
    for (int i = 0; i < 2; ++i) { int R, Cc; stage_rc(tid * 16 + i * 8192, R, Cc); const int Rb = Epi::PERM ? ((R & ~31) + perm32(R & 31)) : R;
        rowA[i] = R; colA[i] = Cc * 2;
        voffA[0][i] = (unsigned)(R * lda + Cc * 2); voffA[1][i] = voffA[0][i] + (unsigned)(HALF * lda); voffB[i] = (unsigned)(Rb * ldb + Cc * 2); }
    const size_t kstep = (size_t)(BK * 2);
    const size_t hstepB = (size_t)HALF * ldb;
    const unsigned ldsw = (unsigned)wid * 1024u;
    const int aoff = lds_byte(wr * 64 + fr, fq * 8), boff = lds_byte(wc * 32 + fr, fq * 8);
#define PG_SA(b, h) (((b) * 2 + (h)) * HTB)
#define PG_SB(b, h) ((4 + (b) * 2 + (h)) * HTB)
#define PG_STAGE_A(bufoff, h, gbase) do { _Pragma("unroll") for (int _i = 0; _i < 2; ++_i) \
        __builtin_amdgcn_global_load_lds((const unsigned*)((const char*)(gbase) + voffA[h][_i]), (LAS unsigned*)(lds + (bufoff) + ldsw + _i * 8192), 16, 0, 0); } while (0)
#define PG_STAGE_B(bufoff, gbase) do { _Pragma("unroll") for (int _i = 0; _i < 2; ++_i) \
        __builtin_amdgcn_global_load_lds((const unsigned*)((const char*)(gbase) + voffB[_i]), (LAS unsigned*)(lds + (bufoff) + ldsw + _i * 8192), 16, 0, 0); } while (0)
#define PG_LDA(dst, b, h) do { _Pragma("unroll") for (int m = 0; m < 4; ++m) _Pragma("unroll") for (int k = 0; k < 2; ++k) dst[m][k] = *(const LAS bf16x8*)(lds + PG_SA(b, h) + aoff + m * 2048 + k * 1024); } while (0)
#define PG_LDB(dst, b, h) do { _Pragma("unroll") for (int n = 0; n < 2; ++n) _Pragma("unroll") for (int k = 0; k < 2; ++k) dst[n][k] = *(const LAS bf16x8*)(lds + PG_SB(b, h) + boff + n * 2048 + k * 1024); } while (0)
#define PG_MMA(ai, bj, At, Bt) do { __builtin_amdgcn_s_setprio(1); _Pragma("unroll") for (int m = 0; m < 4; ++m) _Pragma("unroll") for (int n = 0; n < 2; ++n) _Pragma("unroll") for (int k = 0; k < 2; ++k) \
        acc[ai][bj][m][n] = __builtin_amdgcn_mfma_f32_16x16x32_bf16(Bt[n][k], At[m][k], acc[ai][bj][m][n], 0, 0, 0); __builtin_amdgcn_s_setprio(0); } while (0)
#define PG_WAIT_V(n) asm volatile("s_waitcnt vmcnt(" #n ")" ::: "memory")
#define PG_WAIT_L(n) asm volatile("s_waitcnt lgkmcnt(" #n ")" ::: "memory")
#define PG_BAR __builtin_amdgcn_s_barrier()
#define PG_SCHED __builtin_amdgcn_sched_barrier(0)
#define PG_GATHER(u) do { if constexpr (GATHER) { _Pragma("unroll") for (int _h = 0; _h < 2; ++_h) _Pragma("unroll") for (int _i = 0; _i < 2; ++_i) voffA[_h][_i] = S.row_off(u, _h * HALF + rowA[_i]) + (unsigned)colA[_i]; } } while (0)
    Unit cur, nxt; int ui = 0;
    if (!S.next(0, cur)) return;
    f32x4 acc[2][2][4][2];
#pragma unroll
    for (int a = 0; a < 2; ++a)
#pragma unroll
        for (int b = 0; b < 2; ++b)
#pragma unroll
            for (int m = 0; m < 4; ++m)
#pragma unroll
                for (int n = 0; n < 2; ++n) acc[a][b][m][n] = (f32x4){0.f, 0.f, 0.f, 0.f};
    bf16x8 At[4][2], B0[2][2], B1[2][2];
    const char* cA = launder(cur.A); const char* cB = launder(cur.B);
    PG_GATHER(cur);
    PG_STAGE_B(PG_SB(0, 0), cB); PG_STAGE_B(PG_SB(0, 1), cB + hstepB); PG_STAGE_A(PG_SA(0, 0), 0, cA); PG_STAGE_A(PG_SA(0, 1), 1, cA);
    if (wr == 1) PG_BAR;
    PG_WAIT_V(2); PG_BAR;
    PG_STAGE_B(PG_SB(1, 0), cB + kstep); PG_STAGE_A(PG_SA(1, 0), 0, cA + kstep); PG_STAGE_B(PG_SB(1, 1), cB + hstepB + kstep);
    PG_WAIT_V(6); PG_BAR;
    for (;;) {
        const bool has_next = S.next(ui + 1, nxt);
        const char* nA = launder(has_next ? nxt.A : cA); const char* nB = launder(has_next ? nxt.B : cB);
#pragma unroll 1
        for (int t = 0; t < nt; t += 2) {
            const bool last = (t == nt - 2);
            const char* a1 = cA + (size_t)(t + 1) * kstep;
            const char* a2 = last ? nA : cA + (size_t)(t + 2) * kstep; const char* b2 = last ? nB : cB + (size_t)(t + 2) * kstep;
            const char* a3 = a2 + kstep; const char* b3 = b2 + kstep;
            PG_LDB(B0, 0, 0); PG_LDB(B1, 0, 1); PG_SCHED; PG_LDA(At, 0, 0); PG_STAGE_A(PG_SA(1, 1), 1, a1);
            PG_WAIT_V(8); PG_WAIT_L(0); PG_BAR; PG_MMA(0, 0, At, B0); PG_MMA(0, 1, At, B1); PG_BAR; PG_SCHED;
            if (last && has_next) PG_GATHER(nxt);
            PG_LDA(At, 0, 1); PG_STAGE_B(PG_SB(0, 0), b2); PG_STAGE_B(PG_SB(0, 1), b2 + hstepB); PG_STAGE_A(PG_SA(0, 0), 0, a2);
            PG_WAIT_V(8); PG_WAIT_L(0); PG_BAR; PG_MMA(1, 0, At, B0); PG_MMA(1, 1, At, B1); PG_BAR; PG_SCHED;
            PG_LDB(B0, 1, 0); PG_LDB(B1, 1, 1); PG_SCHED; PG_LDA(At, 1, 0); PG_STAGE_A(PG_SA(0, 1), 1, a2);
            PG_WAIT_V(8); PG_WAIT_L(0); PG_BAR; PG_MMA(0, 0, At, B0); PG_MMA(0, 1, At, B1); PG_BAR; PG_SCHED;
            PG_LDA(At, 1, 1); PG_STAGE_B(PG_SB(1, 0), b3); PG_STAGE_B(PG_SB(1, 1), b3 + hstepB); PG_STAGE_A(PG_SA(1, 0), 0, a3);
            PG_WAIT_V(8); PG_WAIT_L(0); PG_BAR; PG_MMA(1, 0, At, B0); PG_MMA(1, 1, At, B1); PG_BAR; PG_SCHED;
        }
        if (wr == 0) PG_BAR;
        E(acc, cur, wr, wc, fr, fq);
        if (!has_next) break;
#pragma unroll
        for (int a = 0; a < 2; ++a)
#pragma unroll
            for (int b = 0; b < 2; ++b)
#pragma unroll
                for (int m = 0; m < 4; ++m)
#pragma unroll
                    for (int n = 0; n < 2; ++n) acc[a][b][m][n] = (f32x4){0.f, 0.f, 0.f, 0.f};
        cur = nxt; cA = nA; cB = nB; ++ui;
        if (wr == 1) PG_BAR;
    }
    PG_WAIT_V(0);
    PG_BAR;
#undef PG_SA
#undef PG_SB
#undef PG_STAGE_A
#undef PG_STAGE_B
#undef PG_LDA
#undef PG_LDB
#undef PG_MMA
#undef PG_WAIT_V
#undef PG_WAIT_L
#undef PG_BAR
#undef PG_SCHED
#undef PG_GATHER
}
}

#define XB_TMO      128
#define XB_XCNT(j)  (256  + 64 * (j))
#define XB_XSUB(j)  (1280 + 64 * (j))
#define XB_XGEN(j)  (2304 + 64 * (j))
#define XB_TOP      3328
#define XB_TOPGEN   3392
#define XCD_BAR_WORDS 3456
#define XB_SPIN_CAP (1u << 22)
DI unsigned xb_ld(unsigned* p)              { return __hip_atomic_load(p, __ATOMIC_RELAXED, __HIP_MEMORY_SCOPE_AGENT); }
DI unsigned xb_add(unsigned* p, unsigned v) { return __hip_atomic_fetch_add(p, v, __ATOMIC_RELAXED, __HIP_MEMORY_SCOPE_AGENT); }
DI unsigned xb_xcc_id() { return (unsigned)__builtin_amdgcn_s_getreg((3 << 11) | 20) & 0xFu; }
#define XB_SPIN(cond, bar) do { unsigned _sp = 0; while (cond) { __builtin_amdgcn_s_sleep(1); \
    if ((++_sp & 255u) == 0u) { if (xb_ld(&(bar)[XB_TMO])) break; if (_sp > XB_SPIN_CAP) { atomicAdd(&(bar)[XB_TMO], 1u); break; } } } } while (0)
struct XcdBarrier { unsigned* bar; unsigned x; volatile LAS unsigned* st; };
DI XcdBarrier xcd_barrier_post(unsigned* bar, volatile LAS unsigned* st) {
    XcdBarrier b; b.bar = bar; b.x = xb_xcc_id(); b.st = st;
    if (threadIdx.x == 0) (void)xb_add(&bar[XB_XCNT(b.x)], 1u);
    return b;
}
DI void xcd_barrier_complete(unsigned* bar, unsigned x, unsigned& nloc, unsigned& nx) {
    const unsigned G = gridDim.x * gridDim.y * gridDim.z;
    unsigned sum, cnt, mine, sp = 0u;
    for (;;) {
        sum = 0u; cnt = 0u; mine = 0u;
#pragma unroll
        for (unsigned j = 0; j < 16; ++j) { const unsigned c = xb_ld(&bar[XB_XCNT(j)]); sum += c; cnt += (c > 0u) ? 1u : 0u; mine = (j == x) ? c : mine; }
        if (sum == G) break;
        __builtin_amdgcn_s_sleep(1);
        if ((++sp & 255u) == 0u) { if (xb_ld(&bar[XB_TMO])) break; if (sp > XB_SPIN_CAP) { atomicAdd(&bar[XB_TMO], 1u); break; } }
    }
    nloc = mine > 0u ? mine : 1u; nx = cnt > 0u ? cnt : 1u;
}
DI void xcd_barrier(const XcdBarrier& b) {
    asm volatile("s_waitcnt vmcnt(0)" ::: "memory");
    __syncthreads();
    if (threadIdx.x == 0) {
        unsigned* bar = b.bar; asm volatile("" : "+s"(bar));
        __builtin_amdgcn_s_waitcnt(0);
        unsigned nloc = b.st[0], nx = b.st[1];
        if (nloc == 0u) { xcd_barrier_complete(bar, b.x, nloc, nx); b.st[0] = nloc; b.st[1] = nx; }
        const unsigned old = xb_add(&bar[XB_XSUB(b.x)], 1u);
        const unsigned gen = old / nloc;
        if (old + 1u == (gen + 1u) * nloc) {
            __builtin_amdgcn_fence(__ATOMIC_RELEASE, "agent");
            asm volatile("s_waitcnt vmcnt(0)" ::: "memory");
            const unsigned og = xb_add(&bar[XB_TOP], 1u);
            const unsigned tg = og / nx;
            if (og + 1u == (tg + 1u) * nx) xb_add(&bar[XB_TOPGEN], 1u);
            else XB_SPIN(xb_ld(&bar[XB_TOPGEN]) == tg, bar);
            __builtin_amdgcn_fence(__ATOMIC_ACQUIRE, "agent");
            xb_add(&bar[XB_XGEN(b.x)], 1u);
            asm volatile("s_waitcnt vmcnt(0)" ::: "memory");
        } else {
            XB_SPIN(xb_ld(&bar[XB_XGEN(b.x)]) == gen, bar);
            __builtin_amdgcn_fence(__ATOMIC_ACQUIRE, "agent");
            asm volatile("s_waitcnt vmcnt(0)" ::: "memory");
        }
    }
    __syncthreads();
}

struct Args { const void* in[30]; float* out; unsigned char* ws; int l_lo, l_hi, ph_lo, ph_hi; };
enum { I_X = 0, I_POS, I_ATTN_NORM, I_WIN, I_MU, I_W0, I_WUP, I_A0, I_AUP, I_GUP, I_KK, I_KA, I_RK, I_LNG, I_LNB, I_POOLW, I_POOLS, I_QN, I_KN, I_SINK,
       I_WBR, I_WOUT, I_FFN_NORM, I_RGW, I_RGB, I_REW, I_REB, I_W1, I_W3, I_W2 };
constexpr int NPH = 15;

struct Frame {
    LAS unsigned char* lds;
    unsigned char* ws;
    int tid, lane, wave, G, bid, gw, NGW;
};

DI void tr_load(f32x4 (&v)[8], const float* W, int N, int k0, int n0, int lane) {
    const GAS float* p = (const GAS float*)W + (size_t)(k0 + 8 * (lane >> 3)) * N + n0 + 4 * (lane & 7);
#pragma unroll
    for (int i = 0; i < 8; ++i) v[i] = *(const GAS f32x4*)(p + (size_t)i * N);
}
DI void tr_store(const f32x4 (&v)[8], bf16* WT, int K, int dst_row0, int k0, int lane) {
    GAS bf16* q = (GAS bf16*)WT + (size_t)(dst_row0 + 4 * (lane & 7)) * K + k0 + 8 * (lane >> 3);
#pragma unroll
    for (int j = 0; j < 4; ++j) { v4u o; o.x = pk2(v[0][j], v[1][j]); o.y = pk2(v[2][j], v[3][j]); o.z = pk2(v[4][j], v[5][j]); o.w = pk2(v[6][j], v[7][j]);
        *(GAS v4u*)(q + (size_t)j * K) = o; }
}

DI void expert_item(int it, const float* ew1, const float* ew3, const float* ew2, bf16* W13T, bf16* W2T, const float*& W, int& K, int& N, bf16*& WT, int& drow, int& k0, int& n0) {
    const int which = it / 16384, r = it % 16384, e = r / 512, q = r % 512;
    if (which < 2) { const int kb = q / 16, nb = q % 16; n0 = 32 * nb;
        W = (which ? ew3 : ew1) + (size_t)e * D * FF; K = D; N = FF; WT = W13T + (size_t)e * 1024 * D; drow = 256 * (n0 >> 7) + (n0 & 127) + which * 128; k0 = 64 * kb; }
    else { const int kb = q / 64, nb = q % 64; W = ew2 + (size_t)e * FF * D; K = FF; N = D; WT = W2T + (size_t)e * D * FF; drow = 32 * nb; k0 = 64 * kb; n0 = 32 * nb; }
}
DI void expert_items(const float* ew1, const float* ew3, const float* ew2, bf16* W13T, bf16* W2T, int lo, int hi, int w, int nw, int lane) {
#pragma unroll 1
    for (int it = lo + w; it < hi; it += 2 * nw) {
        const int it1 = it + nw; const bool has1 = it1 < hi;
        const float* Wa; const float* Wb2; bf16* Ta; bf16* Tb; int Ka, Na, da, ka, na, Kb, Nb, db, kb2, nb2;
        expert_item(it, ew1, ew3, ew2, W13T, W2T, Wa, Ka, Na, Ta, da, ka, na); expert_item(has1 ? it1 : it, ew1, ew3, ew2, W13T, W2T, Wb2, Kb, Nb, Tb, db, kb2, nb2);
        f32x4 va[8], vb[8];
        tr_load(va, Wa, Na, ka, na, lane); tr_load(vb, Wb2, Nb, kb2, nb2, lane);
        tr_store(va, Ta, Ka, da, ka, lane);
        if (has1) tr_store(vb, Tb, Kb, db, kb2, lane);
    }
}
constexpr int EXP_P11 = 0;

struct DenseSched {
    const char* A; const char* B; size_t tstepA, tstepB; int nM, nN, G, c;
    DI bool next(int i, pg::Unit& u) const { int pm, pn; if (!pg::static_tile((long)i * G + c, nM, nN, pm, pn)) return false; u.pm = pm; u.pn = pn; u.aux = 0; u.A = A + (size_t)pm * tstepA; u.B = B + (size_t)pn * tstepB; return true; }
    DI unsigned row_off(const pg::Unit&, int) const { return 0u; }
};
struct LoraSched {
    const char* Alora; const char* Wl; int G, c;
    DI bool next(int i, pg::Unit& u) const {
        int pm, pn; if (!pg::static_tile((long)i * G + c, 128, 12, pm, pn)) return false; u.pm = pm; u.pn = pn;
        const int ty = pn >> 2, sub = pn & 3; u.aux = ty;
        u.A = Alora + (size_t)pm * 256 * 2048 + ty * 512; u.B = Wl + (size_t)ty * 1024 * 512 + (size_t)sub * 256 * 512; return true; }
    DI unsigned row_off(const pg::Unit&, int) const { return 0u; }
};
struct PoolSched {
    const char* Apool; const char* Wp; int G, c;
    DI bool next(int i, pg::Unit& u) const {
        int pm, pn; if (!pg::static_tile((long)i * G + c, 128, 4, pm, pn)) return false; u.pm = pm; u.pn = pn; u.aux = 3;
        u.A = Apool + (size_t)pm * 256 * 2048 + pn * 512; u.B = Wp + (size_t)pn * 256 * 512; return true; }
    DI unsigned row_off(const pg::Unit&, int) const { return 0u; }
};
struct BranchSched {
    const char* a2; const char* Wb; int G, c;
    DI bool next(int i, pg::Unit& u) const {
        int pm, pn; const int br = i % 3; if (!pg::static_tile((long)(i / 3) * G + c, 128, 8, pm, pn)) return false; u.pm = pm; u.pn = pn; u.aux = br;
        const size_t ao = br == 0 ? A2_AOUT : (br == 1 ? A2_BOUT : A2_COUT);
        u.A = a2 + ao + (size_t)pm * 256 * 2048; u.B = Wb + (size_t)br * 2048 * 2048 + (size_t)pn * 256 * 2048; return true; }
    DI unsigned row_off(const pg::Unit&, int) const { return 0u; }
};
template <int NCOL, size_t BSE, size_t BSN, size_t ASTR> struct MoeSched {
    const char* A; const char* B; int total, G, c; const LAS int* rb2e; const LAS int* rows;
    DI bool next(int i, pg::Unit& u) const {
        const int L = i * G + c; if (L >= total) return false;
        const int rb = L / NCOL, pn = L % NCOL; const int e = __builtin_amdgcn_readfirstlane(rb2e[rb]);
        u.pm = rb; u.pn = pn; u.aux = i; u.A = A + (size_t)rb * ASTR; u.B = B + (size_t)e * BSE + (size_t)pn * BSN; return true; }
    DI unsigned row_off(const pg::Unit& u, int r) const { return (unsigned)rows[u.aux * 256 + r] * 4096u; }
};

struct EpiProj {
    static constexpr bool PERM = true;
    unsigned char* a2;
    DI void operator()(const f32x4 (&acc)[2][2][4][2], const pg::Unit& u, int wr, int wc, int fr, int fq) const {
        bf16* base; int ld, colt;
        if (u.pn < 14) { base = (bf16*)(a2 + A2_Z); ld = ZP; colt = u.pn * 256; }
        else if (u.pn < 18) { base = (bf16*)(a2 + A2_U); ld = C; colt = (u.pn - 14) * 256; }
        else if (u.pn < 22) { base = (bf16*)(a2 + A2_Q); ld = C; colt = (u.pn - 18) * 256; }
        else if (u.pn == 22) { base = (bf16*)(a2 + A2_K); ld = 256; colt = 0; }
        else { base = (bf16*)(a2 + A2_V); ld = 256; colt = 0; }
        const int row0 = u.pm * 256 + wr * 64 + fr, col0 = colt + wc * 32 + 8 * fq;
#pragma unroll
        for (int ai = 0; ai < 2; ++ai)
#pragma unroll
            for (int m = 0; m < 4; ++m) { bf16* rowp = base + (size_t)(row0 + ai * 128 + m * 16) * ld + col0;
#pragma unroll
                for (int bj = 0; bj < 2; ++bj) { const f32x4 v0 = acc[ai][bj][m][0], v1 = acc[ai][bj][m][1];
                    v4u w; w.x = cvt_pk_bf16(v0[0], v0[1]); w.y = cvt_pk_bf16(v0[2], v0[3]); w.z = cvt_pk_bf16(v1[0], v1[1]); w.w = cvt_pk_bf16(v1[2], v1[3]);
                    *(v4u*)(rowp + bj * 128) = w; } }
    }
};
struct EpiLora {
    static constexpr bool PERM = true;
    unsigned char* a2; unsigned char* a3;
    DI void operator()(const f32x4 (&acc)[2][2][4][2], const pg::Unit& u, int wr, int wc, int fr, int fq) const {
        const int ty = u.aux, sub = u.pn & 3;
        const int row0 = u.pm * 256 + wr * 64 + fr, colb = sub * 256 + wc * 32 + 8 * fq;
        unsigned char* pbase = ty == 0 ? a3 + (size_t)PL_W * PLANE : (ty == 1 ? a3 + (size_t)PL_B * PLANE : a2 + A2_G);
#pragma unroll
        for (int ai = 0; ai < 2; ++ai)
#pragma unroll
            for (int m = 0; m < 4; ++m) {
                const int row = row0 + ai * 128 + m * 16; const int b = row >> 14, t = row & (SEQ - 1);
#pragma unroll
                for (int bj = 0; bj < 2; ++bj) {
                    const int col = colb + bj * 128;
                    const f32x4 v0 = acc[ai][bj][m][0], v1 = acc[ai][bj][m][1];
                    const size_t sc_off = ((size_t)((b * NH + (col >> 6)) * SEQ + t) * 64 + (col & 63)) * 2;
                    v4u w; w.x = pkh2(v0[0], v0[1]); w.y = pkh2(v0[2], v0[3]); w.z = pkh2(v1[0], v1[1]); w.w = pkh2(v1[2], v1[3]); *(v4u*)(pbase + sc_off) = w;
                } }
    }
};
struct EpiPool {
    static constexpr bool PERM = true;
    bf16* O;
    DI void operator()(const f32x4 (&acc)[2][2][4][2], const pg::Unit& u, int wr, int wc, int fr, int fq) const {
        const int row0 = u.pm * 256 + wr * 64 + fr, col0 = u.pn * 256 + wc * 32 + 8 * fq;
#pragma unroll
        for (int ai = 0; ai < 2; ++ai)
#pragma unroll
            for (int m = 0; m < 4; ++m) { bf16* rowp = O + (size_t)(row0 + ai * 128 + m * 16) * C + col0;
#pragma unroll
                for (int bj = 0; bj < 2; ++bj) { const f32x4 v0 = acc[ai][bj][m][0], v1 = acc[ai][bj][m][1];
                    v4u w; w.x = cvt_pk_bf16(v0[0], v0[1]); w.y = cvt_pk_bf16(v0[2], v0[3]); w.z = cvt_pk_bf16(v1[0], v1[1]); w.w = cvt_pk_bf16(v1[2], v1[3]);
                    *(v4u*)(rowp + bj * 128) = w; } }
    }
};
struct EpiGates {
    static constexpr bool PERM = true;
    bf16* O;
    DI void operator()(const f32x4 (&acc)[2][2][4][2], const pg::Unit& u, int wr, int wc, int fr, int fq) const {
        const int row0 = u.pm * 256 + wr * 64 + fr, col0 = u.pn * 256 + wc * 32 + 8 * fq;
#pragma unroll
        for (int ai = 0; ai < 2; ++ai)
#pragma unroll
            for (int m = 0; m < 4; ++m) { bf16* rowp = O + (size_t)(row0 + ai * 128 + m * 16) * NGATE + col0;
#pragma unroll
                for (int bj = 0; bj < 2; ++bj) { const f32x4 v0 = acc[ai][bj][m][0], v1 = acc[ai][bj][m][1];
                    v4u w; w.x = cvt_pk_bf16_c(sigmoid_r(v0[0]), sigmoid_r(v0[1])); w.y = cvt_pk_bf16_c(sigmoid_r(v0[2]), sigmoid_r(v0[3]));
                    w.z = cvt_pk_bf16_c(sigmoid_r(v1[0]), sigmoid_r(v1[1])); w.w = cvt_pk_bf16_c(sigmoid_r(v1[2]), sigmoid_r(v1[3]));
                    *(v4u*)(rowp + bj * 128) = w; } }
    }
};
struct EpiBranch {
    static constexpr bool PERM = true;
    const bf16* gates; bf16* merged;
    DI void operator()(const f32x4 (&acc)[2][2][4][2], const pg::Unit& u, int wr, int wc, int fr, int fq) const {
        const int br = u.aux;
        const int row0 = u.pm * 256 + wr * 64 + fr, col0 = u.pn * 256 + wc * 32 + 8 * fq;
#pragma unroll
        for (int ai = 0; ai < 2; ++ai)
#pragma unroll
            for (int mh = 0; mh < 2; ++mh) {
                v4u gv[2][2], pv[2][2];
#pragma unroll
                for (int mm = 0; mm < 2; ++mm)
#pragma unroll
                    for (int bj = 0; bj < 2; ++bj) { const size_t row = (size_t)(row0 + ai * 128 + (2 * mh + mm) * 16); const int col = col0 + bj * 128;
                        gv[mm][bj] = *(const v4u*)(gates + row * NGATE + br * D + col);
                        pv[mm][bj] = (br == 0) ? (v4u){0u, 0u, 0u, 0u} : *(const v4u*)(merged + row * D + col); }
#pragma unroll
                for (int mm = 0; mm < 2; ++mm)
#pragma unroll
                    for (int bj = 0; bj < 2; ++bj) { const int m = 2 * mh + mm; const size_t row = (size_t)(row0 + ai * 128 + m * 16); const int col = col0 + bj * 128;
                        float g[8], p[8], o[8]; unpack_bf8(gv[mm][bj], g); unpack_bf8(pv[mm][bj], p);
                        const f32x4 v0 = acc[ai][bj][m][0], v1 = acc[ai][bj][m][1]; const float v[8] = {v0[0], v0[1], v0[2], v0[3], v1[0], v1[1], v1[2], v1[3]};
#pragma unroll
                        for (int j = 0; j < 8; ++j) o[j] = p[j] + g[j] * v[j];
                        *(v4u*)(merged + row * D + col) = pack_bf8(o); }
                asm volatile("" ::: "memory"); }
    }
};
struct EpiResid {
    static constexpr bool PERM = false;
    const float* xin; float* out;
    DI void operator()(const f32x4 (&acc)[2][2][4][2], const pg::Unit& u, int wr, int wc, int fr, int fq) const {
        const int row0 = u.pm * 256 + wr * 64 + fr, col0 = u.pn * 256 + wc * 32 + 4 * fq;
#pragma unroll
        for (int ai = 0; ai < 2; ++ai) {
            f32x4 xv[4][2][2];
#pragma unroll
            for (int m = 0; m < 4; ++m)
#pragma unroll
                for (int bj = 0; bj < 2; ++bj)
#pragma unroll
                    for (int n = 0; n < 2; ++n) xv[m][bj][n] = *(const f32x4*)(xin + (size_t)(row0 + ai * 128 + m * 16) * D + col0 + bj * 128 + n * 16);
#pragma unroll
            for (int m = 0; m < 4; ++m)
#pragma unroll
                for (int bj = 0; bj < 2; ++bj)
#pragma unroll
                    for (int n = 0; n < 2; ++n) *(f32x4*)(out + (size_t)(row0 + ai * 128 + m * 16) * D + col0 + bj * 128 + n * 16) = xv[m][bj][n] + acc[ai][bj][m][n];
            asm volatile("" ::: "memory"); }
    }
};
struct EpiRouter {
    static constexpr bool PERM = false;
    float* L;
    DI void operator()(const f32x4 (&acc)[2][2][4][2], const pg::Unit& u, int wr, int wc, int fr, int fq) const {
        if (wc >= 2) return;
        const int row0 = u.pm * 256 + wr * 64 + fr, col0 = wc * 32 + 4 * fq;
#pragma unroll
        for (int ai = 0; ai < 2; ++ai)
#pragma unroll
            for (int m = 0; m < 4; ++m) { float* rp = L + (size_t)(row0 + ai * 128 + m * 16) * 64 + col0;
#pragma unroll
                for (int n = 0; n < 2; ++n) *(f32x4*)(rp + n * 16) = acc[ai][0][m][n]; }
    }
};
struct EpiMoeUp {
    static constexpr bool PERM = true;
    bf16* HM;
    DI void operator()(const f32x4 (&acc)[2][2][4][2], const pg::Unit& u, int wr, int wc, int fr, int fq) const {
        const int row0 = u.pm * 256 + wr * 64 + fr, col0 = u.pn * 128 + wc * 32 + 8 * fq;
#pragma unroll
        for (int ai = 0; ai < 2; ++ai)
#pragma unroll
            for (int m = 0; m < 4; ++m) { bf16* rowp = HM + (size_t)(row0 + ai * 128 + m * 16) * FF + col0;
                float o[8];
#pragma unroll
                for (int n = 0; n < 2; ++n)
#pragma unroll
                    for (int j = 0; j < 4; ++j) { const float a = acc[ai][0][m][n][j], b = acc[ai][1][m][n][j]; o[n * 4 + j] = a * sigmoid_r(a) * b; }
                *(v4u*)rowp = pack_bf8(o); }
    }
};
struct EpiMoeDown {
    static constexpr bool PERM = true;
    bf16* Y2; const LAS int* rows;
    DI void operator()(const f32x4 (&acc)[2][2][4][2], const pg::Unit& u, int wr, int wc, int fr, int fq) const {
        const int col0 = u.pn * 256 + wc * 32 + 8 * fq;
#pragma unroll
        for (int ai = 0; ai < 2; ++ai)
#pragma unroll
            for (int m = 0; m < 4; ++m) { const int dest = rows[u.aux * 256 + wr * 64 + fr + ai * 128 + m * 16];
                if (dest >= 0) { bf16* rowp = Y2 + (size_t)dest * D + col0;
#pragma unroll
                    for (int bj = 0; bj < 2; ++bj) { const f32x4 v0 = acc[ai][bj][m][0], v1 = acc[ai][bj][m][1];
                        v4u w; w.x = cvt_pk_bf16(v0[0], v0[1]); w.y = cvt_pk_bf16(v0[2], v0[3]); w.z = cvt_pk_bf16(v1[0], v1[1]); w.w = cvt_pk_bf16(v1[2], v1[3]);
                        *(v4u*)(rowp + bj * 128) = w; } } }
    }
};

DI void rms_store(const f32x4 (&v)[8], const float* gain, bf16* orow, int lane) {
    float s = 0.f;
#pragma unroll
    for (int j = 0; j < 8; ++j) s += (v[j].x * v[j].x + v[j].y * v[j].y) + (v[j].z * v[j].z + v[j].w * v[j].w);
    const float rstd = __builtin_amdgcn_rsqf(wave_sum(s) * (1.0f / D) + NORM_EPS);
    GAS v2u* o8 = (GAS v2u*)orow + lane;
#pragma unroll
    for (int j = 0; j < 8; ++j) { const f32x4 g = ((const f32x4*)gain)[lane + 64 * j]; v2u w; w.x = pk2(v[j].x * rstd * g.x, v[j].y * rstd * g.y); w.y = pk2(v[j].z * rstd * g.z, v[j].w * rstd * g.w); o8[64 * j] = w; }
}
DI void moe_combine(f32x4 (&v)[8], const bf16* Y2, const float* tg, int tok, int lane) {
    const float g0 = tg[2 * tok], g1 = tg[2 * tok + 1];
    const GAS v2u* y0 = (const GAS v2u*)(Y2 + (size_t)(2 * tok) * D) + lane; const GAS v2u* y1 = (const GAS v2u*)(Y2 + (size_t)(2 * tok + 1) * D) + lane;
#pragma unroll
    for (int j = 0; j < 8; ++j) { const v2u a = y0[64 * j], b = y1[64 * j];
        v[j].x += g0 * bflo(a.x) + g1 * bflo(b.x); v[j].y += g0 * bfhi(a.x) + g1 * bfhi(b.x); v[j].z += g0 * bflo(a.y) + g1 * bflo(b.y); v[j].w += g0 * bfhi(a.y) + g1 * bfhi(b.y); }
}

struct RowIn { f32x4 x[8]; v2u y0[8], y1[8]; float g0, g1; };
DI void rowin_load(RowIn& r, const float* xsrc, const bf16* Y2, const float* tg, bool comb, int tok, int lane) {
    const GAS f32x4* xr = (const GAS f32x4*)(xsrc + (size_t)tok * D) + lane;
#pragma unroll
    for (int j = 0; j < 8; ++j) r.x[j] = xr[64 * j];
    if (comb) { r.g0 = tg[2 * tok]; r.g1 = tg[2 * tok + 1];
        const GAS v2u* y0 = (const GAS v2u*)(Y2 + (size_t)(2 * tok) * D) + lane; const GAS v2u* y1 = (const GAS v2u*)(Y2 + (size_t)(2 * tok + 1) * D) + lane;
#pragma unroll
        for (int j = 0; j < 8; ++j) { r.y0[j] = y0[64 * j]; r.y1[j] = y1[64 * j]; } }
}
DI void rowin_combine(RowIn& r) {
#pragma unroll
    for (int j = 0; j < 8; ++j) { const v2u a = r.y0[j], b = r.y1[j];
        r.x[j].x += r.g0 * bflo(a.x) + r.g1 * bflo(b.x); r.x[j].y += r.g0 * bfhi(a.x) + r.g1 * bfhi(b.x); r.x[j].z += r.g0 * bflo(a.y) + r.g1 * bflo(b.y); r.x[j].w += r.g0 * bfhi(a.y) + r.g1 * bfhi(b.y); }
}
DI void prep_block(const Frame& F, int blk, const unsigned char* a2, unsigned char* a3, unsigned char* a4, const float* mu, const float* k_k,
                   const float* qn, const float* kn, const int* positions) {
    const int lane = F.lane, t0 = blk * 16, b = t0 >> 14, tl0 = t0 & (SEQ - 1);
    const bf16* Z = (const bf16*)(a2 + A2_Z); const bf16* U = (const bf16*)(a2 + A2_U);
    v4u zprev[7];
#pragma unroll
    for (int it = 0; it < 7; ++it) { const int ci = lane + 64 * it; zprev[it] = (tl0 > 0 && ci < 440) ? *(const GAS v4u*)(Z + (size_t)(t0 - 1) * ZP + ci * 8) : (v4u){0u, 0u, 0u, 0u}; }
    float ps[2][8];
#pragma unroll
    for (int it = 0; it < 2; ++it) {
        const int ci = lane + 64 * it, m = 2 << (ci >> 5);
        v4u pr[15];
#pragma unroll
        for (int d = 1; d < 16; ++d) pr[d - 1] = (d < m && tl0 - d >= 0) ? *(const GAS v4u*)(U + (size_t)(t0 - d) * C + ci * 8) : (v4u){0u, 0u, 0u, 0u};
#pragma unroll
        for (int j = 0; j < 8; ++j) ps[it][j] = 0.f;
#pragma unroll
        for (int d = 0; d < 15; ++d) { float p[8]; unpack_bf8(pr[d], p);
#pragma unroll
            for (int j = 0; j < 8; ++j) ps[it][j] += p[j]; }
    }
    const int l = lane & 31, hw = lane >> 5;
    const float inv_freq = exp2f(-(float)l * 0.41524101186092029f);
    const float gq1 = qn[l], gq2 = qn[l + 32], gk1 = kn[l], gk2 = kn[l + 32];
#pragma unroll 1
    for (int jt = 0; jt < 16; ++jt) {
        const int tok = t0 + jt, t = tl0 + jt;
        bf16* Alora = (bf16*)(a4 + A4_LORA) + (size_t)tok * 1024;
        v4u zc[7], uc[2], uo[2];
#pragma unroll
        for (int it = 0; it < 7; ++it) { const int ci = lane + 64 * it; zc[it] = ci < 440 ? *(const GAS v4u*)(Z + (size_t)tok * ZP + ci * 8) : (v4u){0u, 0u, 0u, 0u}; }
#pragma unroll
        for (int it = 0; it < 2; ++it) { const int ci = lane + 64 * it, m = 2 << (ci >> 5);
            uc[it] = *(const GAS v4u*)(U + (size_t)tok * C + ci * 8);
            uo[it] = (t >= m - 1) ? *(const GAS v4u*)(U + (size_t)(tok - (m - 1)) * C + ci * 8) : (v4u){0u, 0u, 0u, 0u}; }
        bf16* Q = (bf16*)(a2 + A2_Q) + (size_t)tok * C; bf16* Kp = (bf16*)(a2 + A2_K) + (size_t)tok * 256;
        unsigned short x1r[10], x2r[10];
#pragma unroll
        for (int i = 0; i < 10; ++i) { const int hd = 2 * i + hw; const bf16* p = hd < 16 ? Q + hd * 64 : Kp + (hd - 16) * 64; x1r[i] = p[l]; x2r[i] = p[l + 32]; }
        const float pos = (float)positions[tok];
#pragma unroll
        for (int it = 0; it < 7; ++it) {
            const int ci = lane + 64 * it;
            if (ci < 440) {
                float cur[8], prv[8], o[8];
                unpack_bf8(zc[it], cur); unpack_bf8(zprev[it], prv);
                const f32x4 m0 = *(const f32x4*)(mu + ci * 8), m1 = *(const f32x4*)(mu + ci * 8 + 4); const float mm[8] = {m0[0], m0[1], m0[2], m0[3], m1[0], m1[1], m1[2], m1[3]};
#pragma unroll
                for (int j = 0; j < 8; ++j) o[j] = cur[j] + (prv[j] - cur[j]) * mm[j];
                if (ci < 384) {
                    const int reg = ci >> 7, hc = ci & 127;
                    const size_t sc_off = ((size_t)((b * NH + (hc >> 3)) * SEQ + t) * 64 + (hc & 7) * 8) * 2;
                    const int pl = reg == 0 ? PL_R : (reg == 1 ? PL_K : PL_V);
                    *(GAS v4u*)(a3 + (size_t)pl * PLANE + sc_off) = pack_h8(o);
                    if (reg == 1) {
                        const f32x4 q0 = *(const f32x4*)(k_k + hc * 8), q1 = *(const f32x4*)(k_k + hc * 8 + 4); const float kq[8] = {q0[0], q0[1], q0[2], q0[3], q1[0], q1[1], q1[2], q1[3]};
                        float kk[8], ss = 0.f;
#pragma unroll
                        for (int j = 0; j < 8; ++j) { kk[j] = o[j] * kq[j]; ss += kk[j] * kk[j]; }
                        ss = grp8_sum(ss);
                        const float inv = __builtin_amdgcn_rsqf(fmaxf(ss, 1e-24f));
#pragma unroll
                        for (int j = 0; j < 8; ++j) kk[j] *= inv;
                        *(GAS v4u*)(a3 + (size_t)PL_KK * PLANE + sc_off) = pack_h8(kk);
                    }
                } else if (ci < 396) {
#pragma unroll
                    for (int j = 0; j < 8; ++j) o[j] = 1.0f - 2.0f * rcpf_(1.0f + __expf(2.0f * o[j]));
                    *(GAS v4u*)(Alora + (ci - 384) * 8) = pack_bf8(o);
                } else if (ci < 408) {
                    *(GAS v4u*)(Alora + 256 + (ci - 396) * 8) = pack_bf8(o);
                } else {
#pragma unroll
                    for (int j = 0; j < 8; ++j) o[j] = sigmoid_r(o[j]);
                    *(GAS v4u*)(Alora + 512 + (ci - 408) * 8) = pack_bf8(o);
                }
            }
            zprev[it] = zc[it];
        }
        if (lane < 40) { const int cc = lane < 20 ? 96 + lane * 8 : 352 + (lane - 20) * 8; *(GAS v4u*)(Alora + cc) = (v4u){0u, 0u, 0u, 0u}; }
        {
            bf16* Ap = (bf16*)(a4 + A4_POOL) + (size_t)tok * C;
#pragma unroll
            for (int it = 0; it < 2; ++it) {
                const int ci = lane + 64 * it, m = 2 << (ci >> 5);
                const int cnt = (t + 1) < m ? (t + 1) : m;
                float cur[8], old[8], o[8];
                unpack_bf8(uc[it], cur); unpack_bf8(uo[it], old);
                const float ic = 1.0f / (float)cnt;
#pragma unroll
                for (int j = 0; j < 8; ++j) { const float sw = ps[it][j] + cur[j]; o[j] = sw * ic - cur[j]; ps[it][j] = sw - old[j]; }
                *(GAS v4u*)(Ap + ci * 8) = pack_bf8(o);
            }
        }
        {
            float sn, cs; sincosf(pos * inv_freq, &sn, &cs);
#pragma unroll
            for (int i = 0; i < 10; ++i) {
                const int hd = 2 * i + hw; const bool isq = hd < 16;
                bf16* p = isq ? Q + hd * 64 : Kp + (hd - 16) * 64;
                float x1 = bflo((unsigned)x1r[i]), x2 = bflo((unsigned)x2r[i]);
                float ss = x1 * x1 + x2 * x2;
                ss = grp32_sum(ss);
                const float rs = __builtin_amdgcn_rsqf(ss * (1.0f / 64.0f) + NORM_EPS);
                x1 = x1 * rs * (isq ? gq1 : gk1); x2 = x2 * rs * (isq ? gq2 : gk2);
                const float o1 = x1 * cs - x2 * sn, o2 = x2 * cs + x1 * sn;
                p[l] = (bf16)f2bf(o1); p[l + 32] = (bf16)f2bf(o2);
            }
        }
    }
}

struct FinIn { v4u w[2], a[2], k[2], kk[2]; };
DI size_t sc_off_of(int tok, int ci) { const int b = tok >> 14, t = tok & (SEQ - 1); return ((size_t)((b * NH + (ci >> 3)) * SEQ + t) * 64 + (ci & 7) * 8) * 2; }
DI void fin_load(FinIn& f, const unsigned char* a3, int tok, int lane) {
#pragma unroll
    for (int it = 0; it < 2; ++it) { const size_t o = sc_off_of(tok, lane + 64 * it);
        f.w[it] = *(const GAS v4u*)(a3 + (size_t)PL_W * PLANE + o); f.a[it] = *(const GAS v4u*)(a3 + (size_t)PL_B * PLANE + o);
        f.k[it] = *(const GAS v4u*)(a3 + (size_t)PL_K * PLANE + o); f.kk[it] = *(const GAS v4u*)(a3 + (size_t)PL_KK * PLANE + o); }
}
DI void fin_body(const FinIn& cur, int m, int lane, unsigned char* a3, const float (&pw)[2][8], const float (&pa)[2][8], const float (&ka)[2][8]) {
#pragma unroll
    for (int it = 0; it < 2; ++it) {
        const size_t o = sc_off_of(m, lane + 64 * it);
        float wr_[8], ar_[8], ks[8], kk[8], wo[8], ko[8], bo[8];
        unpack_h8(cur.w[it], wr_); unpack_h8(cur.a[it], ar_); unpack_h8(cur.k[it], ks); unpack_h8(cur.kk[it], kk);
#pragma unroll
        for (int j = 0; j < 8; ++j) {
            wo[j] = __expf(-0.6065306597f * sigmoidf_(pw[it][j] + wr_[j]));
            const float a = sigmoidf_(pa[it][j] + ar_[j]);
            ko[j] = ks[j] * (1.0f + (a - 1.0f) * ka[it][j]); bo[j] = kk[j] * a; }
        *(GAS v4u*)(a3 + (size_t)PL_W * PLANE + o) = pack_h8(wo); *(GAS v4u*)(a3 + (size_t)PL_K * PLANE + o) = pack_h8(ko); *(GAS v4u*)(a3 + (size_t)PL_B * PLANE + o) = pack_h8(bo);
    }
}
DI void finalize_phase(const Frame& F, unsigned char* a3, const float* w0, const float* a0, const float* k_a) {
    const int lane = F.lane;
    float pw[2][8], pa[2][8], ka[2][8];
#pragma unroll
    for (int it = 0; it < 2; ++it) { const int ci = lane + 64 * it;
        const f32x4 p0 = *(const f32x4*)(w0 + ci * 8), p1 = *(const f32x4*)(w0 + ci * 8 + 4), q0 = *(const f32x4*)(a0 + ci * 8), q1 = *(const f32x4*)(a0 + ci * 8 + 4), r0 = *(const f32x4*)(k_a + ci * 8), r1 = *(const f32x4*)(k_a + ci * 8 + 4);
#pragma unroll
        for (int j = 0; j < 4; ++j) { pw[it][j] = p0[j]; pw[it][4 + j] = p1[j]; pa[it][j] = q0[j]; pa[it][4 + j] = q1[j]; ka[it][j] = r0[j]; ka[it][4 + j] = r1[j]; } }
#pragma unroll 1
    for (int m = F.gw; m < NT; m += 2 * F.NGW) {
        const int m1 = m + F.NGW; const bool has1 = m1 < NT;
        FinIn fa, fb;
        fin_load(fa, a3, m, lane); fin_load(fb, a3, has1 ? m1 : m, lane);
        fin_body(fa, m, lane, a3, pw, pa, ka);
        if (has1) fin_body(fb, m1, lane, a3, pw, pa, ka);
    }
}

DI void postscan_phase(const Frame& F, unsigned char* a2, const unsigned char* a3, const float* ln_g, const float* ln_b, const float* bonus) {
    const int lane = F.lane;
    float lg[2][8], lb[2][8];
#pragma unroll
    for (int it = 0; it < 2; ++it) { const int ci = lane + 64 * it;
        const f32x4 q0 = *(const f32x4*)(ln_g + ci * 8), q1 = *(const f32x4*)(ln_g + ci * 8 + 4), r0 = *(const f32x4*)(ln_b + ci * 8), r1 = *(const f32x4*)(ln_b + ci * 8 + 4);
#pragma unroll
        for (int j = 0; j < 4; ++j) { lg[it][j] = q0[j]; lg[it][4 + j] = q1[j]; lb[it][j] = r0[j]; lb[it][4 + j] = r1[j]; } }
#pragma unroll 1
    for (int qd = F.gw; qd < NT / 4; qd += F.NGW) {
        const int tok0 = qd * 4, b = tok0 >> 14, t0 = tok0 & (SEQ - 1);
        v4u yq[2][4], vv[2][4], gg[2][4]; float bn[2][4];
#pragma unroll
        for (int it = 0; it < 2; ++it) { const int ci = lane + 64 * it, chain = b * NH + (ci >> 3);
            const GAS v4u* yp = (const GAS v4u*)(a2 + A2_Y + (((size_t)chain * (SEQ / 4) + (t0 >> 2)) * 64 + (ci & 7) * 8) * 8);
#pragma unroll
            for (int k4 = 0; k4 < 4; ++k4) yq[it][k4] = yp[k4];
#pragma unroll
            for (int tt = 0; tt < 4; ++tt) { const size_t o = sc_off_of(tok0 + tt, ci);
                vv[it][tt] = *(const GAS v4u*)(a3 + (size_t)PL_V * PLANE + o); gg[it][tt] = *(const GAS v4u*)(a2 + A2_G + o);
                bn[it][tt] = bonus[(size_t)chain * SEQ + t0 + tt]; } }
#pragma unroll
        for (int it = 0; it < 2; ++it) {
            const int ci = lane + 64 * it;
            const unsigned yw[16] = {yq[it][0].x, yq[it][0].y, yq[it][0].z, yq[it][0].w, yq[it][1].x, yq[it][1].y, yq[it][1].z, yq[it][1].w,
                                     yq[it][2].x, yq[it][2].y, yq[it][2].z, yq[it][2].w, yq[it][3].x, yq[it][3].y, yq[it][3].z, yq[it][3].w};
#pragma unroll
            for (int tt = 0; tt < 4; ++tt) {
                float y[8], v[8], g[8], o[8];
#pragma unroll
                for (int j = 0; j < 8; ++j) { const unsigned w = yw[2 * j + (tt >> 1)]; y[j] = (tt & 1) ? bfhi(w) : bflo(w); }
                unpack_h8(vv[it][tt], v); unpack_h8(gg[it][tt], g);
                float s1 = 0.f;
#pragma unroll
                for (int j = 0; j < 8; ++j) s1 += y[j];
                s1 = grp8_sum(s1);
                const float mean = s1 * (1.0f / 64.0f); float s2 = 0.f;
#pragma unroll
                for (int j = 0; j < 8; ++j) { const float d = y[j] - mean; s2 += d * d; }
                s2 = grp8_sum(s2);
                const float rstd = __builtin_amdgcn_rsqf(s2 * (1.0f / 64.0f) + GN_EPS);
#pragma unroll
                for (int j = 0; j < 8; ++j) o[j] = ((y[j] - mean) * rstd * lg[it][j] + lb[it][j] + bn[it][tt] * v[j]) * g[j];
                *(GAS v4u*)(a2 + A2_AOUT + ((size_t)(tok0 + tt) * C + ci * 8) * 2) = pack_bf8(o);
            }
        }
    }
}

DI float ar16(float x) {
    x += __builtin_bit_cast(float, __builtin_amdgcn_update_dpp(0, __builtin_bit_cast(int, x), 0x128, 0xf, 0xf, false));
    x += __builtin_bit_cast(float, __builtin_amdgcn_update_dpp(0, __builtin_bit_cast(int, x), 0x124, 0xf, 0xf, false));
    x += __builtin_bit_cast(float, __builtin_amdgcn_update_dpp(0, __builtin_bit_cast(int, x), 0x122, 0xf, 0xf, false));
    x += __builtin_bit_cast(float, __builtin_amdgcn_update_dpp(0, __builtin_bit_cast(int, x), 0x121, 0xf, 0xf, false));
    return x;
}
constexpr int SCAN_TB = 32, SCAN_BUF = 6 * SCAN_TB * 128;
DI void scan_stage(const unsigned char* a3, size_t gofs, LAS unsigned char* buf, int tid, int wave) {
#pragma unroll
    for (int r = 0; r < 3; ++r) { const int o = (r * 512 + tid) * 16; const int pl = o >> 12, within = o & 4095;
        __builtin_amdgcn_global_load_lds((const unsigned*)(a3 + (size_t)pl * PLANE + gofs + within), (LAS unsigned*)(buf + r * 8192 + wave * 1024), 16, 0, 0); }
}
struct ScanOp { v2u r, w, k, kk, b; unsigned v; };
DI void scan_ld(ScanOp& o, const LAS unsigned char* cb, int j, int o4, int ov) {
    o.kk = *(const LAS v2u*)(cb + PL_KK * 4096 + j * 128 + o4); o.w = *(const LAS v2u*)(cb + PL_W * 4096 + j * 128 + o4); o.k = *(const LAS v2u*)(cb + PL_K * 4096 + j * 128 + o4);
    o.b = *(const LAS v2u*)(cb + PL_B * 4096 + j * 128 + o4); o.r = *(const LAS v2u*)(cb + PL_R * 4096 + j * 128 + o4); o.v = (unsigned)*(const LAS unsigned short*)(cb + PL_V * 4096 + j * 128 + ov);
}
DI void scan_step(float& s0, float& s1, float& s2, float& s3, float& y, float& yp, const ScanOp& c) {
    float d, t0, t1, t2, t3;
    asm("v_fma_mix_f32 %[d], %[s0], %[kkx], 0 op_sel:[0,0,0] op_sel_hi:[0,1,0]\n\t"
        "v_add_f32_dpp %[y], %[y], %[y] row_ror:8 row_mask:0xf bank_mask:0xf\n\t"
        "v_fma_mix_f32 %[d], %[s1], %[kkx], %[d] op_sel:[0,1,0] op_sel_hi:[0,1,0]\n\t"
        "v_fma_mix_f32 %[d], %[s2], %[kky], %[d] op_sel:[0,0,0] op_sel_hi:[0,1,0]\n\t"
        "v_add_f32_dpp %[y], %[y], %[y] row_ror:4 row_mask:0xf bank_mask:0xf\n\t"
        "v_fma_mix_f32 %[d], %[s3], %[kky], %[d] op_sel:[0,1,0] op_sel_hi:[0,1,0]\n\t"
        "v_fma_mix_f32 %[t0], %[v], %[kx], 0 op_sel:[0,0,0] op_sel_hi:[1,1,0]\n\t"
        "v_add_f32_dpp %[y], %[y], %[y] row_ror:2 row_mask:0xf bank_mask:0xf\n\t"
        "v_fma_mix_f32 %[t1], %[v], %[kx], 0 op_sel:[0,1,0] op_sel_hi:[1,1,0]\n\t"
        "v_fma_mix_f32 %[t2], %[v], %[ky], 0 op_sel:[0,0,0] op_sel_hi:[1,1,0]\n\t"
        "v_add_f32_dpp %[y], %[y], %[y] row_ror:1 row_mask:0xf bank_mask:0xf\n\t"
        "v_add_f32_dpp %[d], %[d], %[d] row_ror:8 row_mask:0xf bank_mask:0xf\n\t"
        "v_fma_mix_f32 %[t3], %[v], %[ky], 0 op_sel:[0,1,0] op_sel_hi:[1,1,0]\n\t"
        "v_fma_mix_f32 %[t0], %[s0], %[wx], %[t0] op_sel:[0,0,0] op_sel_hi:[0,1,0]\n\t"
        "v_add_f32_dpp %[d], %[d], %[d] row_ror:4 row_mask:0xf bank_mask:0xf\n\t"
        "v_fma_mix_f32 %[t1], %[s1], %[wx], %[t1] op_sel:[0,1,0] op_sel_hi:[0,1,0]\n\t"
        "v_fma_mix_f32 %[t2], %[s2], %[wy], %[t2] op_sel:[0,0,0] op_sel_hi:[0,1,0]\n\t"
        "v_add_f32_dpp %[d], %[d], %[d] row_ror:2 row_mask:0xf bank_mask:0xf\n\t"
        "v_fma_mix_f32 %[t3], %[s3], %[wy], %[t3] op_sel:[0,1,0] op_sel_hi:[0,1,0]\n\t"
        "s_nop 0\n\t"
        "v_add_f32_dpp %[d], %[d], %[d] row_ror:1 row_mask:0xf bank_mask:0xf\n\t"
        "v_fma_mix_f32 %[s0], -%[d], %[bx], %[t0] op_sel:[0,0,0] op_sel_hi:[0,1,0]\n\t"
        "v_fma_mix_f32 %[s1], -%[d], %[bx], %[t1] op_sel:[0,1,0] op_sel_hi:[0,1,0]\n\t"
        "v_fma_mix_f32 %[s2], -%[d], %[by], %[t2] op_sel:[0,0,0] op_sel_hi:[0,1,0]\n\t"
        "v_fma_mix_f32 %[s3], -%[d], %[by], %[t3] op_sel:[0,1,0] op_sel_hi:[0,1,0]\n\t"
        "v_fma_mix_f32 %[yp], %[s0], %[rx], 0 op_sel:[0,0,0] op_sel_hi:[0,1,0]\n\t"
        "v_fma_mix_f32 %[yp], %[s1], %[rx], %[yp] op_sel:[0,1,0] op_sel_hi:[0,1,0]\n\t"
        "v_fma_mix_f32 %[yp], %[s2], %[ry], %[yp] op_sel:[0,0,0] op_sel_hi:[0,1,0]\n\t"
        "v_fma_mix_f32 %[yp], %[s3], %[ry], %[yp] op_sel:[0,1,0] op_sel_hi:[0,1,0]\n\t"
        "s_nop 1"
        : [s0] "+v"(s0), [s1] "+v"(s1), [s2] "+v"(s2), [s3] "+v"(s3), [y] "+v"(y), [yp] "=&v"(yp), [d] "=&v"(d), [t0] "=&v"(t0), [t1] "=&v"(t1), [t2] "=&v"(t2), [t3] "=&v"(t3)
        : [kkx] "v"(c.kk.x), [kky] "v"(c.kk.y), [wx] "v"(c.w.x), [wy] "v"(c.w.y), [kx] "v"(c.k.x), [ky] "v"(c.k.y), [bx] "v"(c.b.x), [by] "v"(c.b.y), [rx] "v"(c.r.x), [ry] "v"(c.r.y), [v] "v"(c.v));
}
DI void scan_chain(const Frame& F, int s, const unsigned char* a3, unsigned char* a2) {
    const int lane = F.lane, chain = s >> 2, row = 16 * (s & 3) + 4 * (F.wave & 3) + (lane >> 4), ki = lane & 15;
    const bool worker = F.wave < 4;
    float S0 = 0.f, S1 = 0.f, S2 = 0.f, S3 = 0.f, ycar = 0.f;
    GAS bf16* Y = (GAS bf16*)(a2 + A2_Y) + (size_t)chain * SEQ * 64 + row;
    const size_t g0 = (size_t)chain * SEQ * 128;
    LAS unsigned char* lbuf = F.lds;
    const int o4 = ki * 8, ov = row * 2;
    scan_stage(a3, g0, lbuf, F.tid, F.wave);
    asm volatile("s_waitcnt vmcnt(0)" ::: "memory"); __syncthreads();
#pragma unroll 1
    for (int blk = 0; blk < SEQ / SCAN_TB; ++blk) {
        const LAS unsigned char* cb = lbuf + (blk & 1) * SCAN_BUF;
        if (blk + 1 < SEQ / SCAN_TB) scan_stage(a3, g0 + (size_t)(blk + 1) * SCAN_TB * 128, lbuf + ((blk + 1) & 1) * SCAN_BUF, F.tid, F.wave);
        if (worker) {
            float yk0 = 0.f, yk1 = 0.f;
            ScanOp op[3];
            scan_ld(op[0], cb, 0, o4, ov); scan_ld(op[1], cb, 1, o4, ov);
#pragma unroll
            for (int j = 0; j < SCAN_TB; ++j) {
                if (j + 2 < SCAN_TB) scan_ld(op[(j + 2) % 3], cb, j + 2, o4, ov);
                asm volatile("" ::: "memory");
                float yp; scan_step(S0, S1, S2, S3, ycar, yp, op[j % 3]);
                if (j < 16) yk0 = (ki == j) ? ycar : yk0; else yk1 = (ki == j - 16) ? ycar : yk1;
                ycar = yp;
            }
            if (blk > 0 || ki > 0) Y[(long)(blk * SCAN_TB - 1 + ki) * 64] = (bf16)f2bf(yk0);
            Y[(size_t)(blk * SCAN_TB + 15 + ki) * 64] = (bf16)f2bf(yk1);
        }
        asm volatile("s_waitcnt vmcnt(0)" ::: "memory"); __syncthreads();
    }
    if (worker) { const float yl = ar16(ycar); if (ki == 0) Y[(size_t)(SEQ - 1) * 64] = (bf16)f2bf(yl); }
}

typedef _Float16 h16x8 __attribute__((ext_vector_type(8)));
DI s16x4 tr_read(unsigned lds_addr);
#define MFMA16H(a, b, c) __builtin_amdgcn_mfma_f32_16x16x32_f16((a), (b), (c), 0, 0, 0)
constexpr int CH_L = 16, CH_NSEG = 8, CH_SEGCH = 128;
constexpr int SC_AG = 0, SC_RG = 2048, SC_BG = 4096, SC_KG = 6144, SC_AP = 8192, SC_ZT = 10240, SC_WT = 12288, SC_AK = 12800, SC_ABT = 13312, SC_RB = 14336, SC_RK = 15360, SC_BYTES = 16384;
DI void tr_frag4(unsigned base, int k0, int i16, h16x8& fa, h16x8& fr, h16x8& fb, h16x8& fk) {
    const unsigned a0 = base + (unsigned)(k0 + (i16 >> 2)) * 32u + 8u * (i16 & 3), a1 = a0 + 128u;
    s16x4 l0, h0, l1, h1, l2, h2, l3, h3;
    asm volatile("ds_read_b64_tr_b16 %0, %8\n\tds_read_b64_tr_b16 %1, %9\n\tds_read_b64_tr_b16 %2, %8 offset:2048\n\tds_read_b64_tr_b16 %3, %9 offset:2048\n\t"
                 "ds_read_b64_tr_b16 %4, %8 offset:4096\n\tds_read_b64_tr_b16 %5, %9 offset:4096\n\tds_read_b64_tr_b16 %6, %8 offset:6144\n\tds_read_b64_tr_b16 %7, %9 offset:6144\n\ts_waitcnt lgkmcnt(0)"
                 : "=&v"(l0), "=&v"(h0), "=&v"(l1), "=&v"(h1), "=&v"(l2), "=&v"(h2), "=&v"(l3), "=&v"(h3) : "v"(a0), "v"(a1) : "memory");
    fa = __builtin_bit_cast(h16x8, __builtin_shufflevector(l0, h0, 0, 1, 2, 3, 4, 5, 6, 7)); fr = __builtin_bit_cast(h16x8, __builtin_shufflevector(l1, h1, 0, 1, 2, 3, 4, 5, 6, 7));
    fb = __builtin_bit_cast(h16x8, __builtin_shufflevector(l2, h2, 0, 1, 2, 3, 4, 5, 6, 7)); fk = __builtin_bit_cast(h16x8, __builtin_shufflevector(l3, h3, 0, 1, 2, 3, 4, 5, 6, 7));
}
DI v4u pack16h(const float (&x)[16], int o) { v4u w; w.x = pkh2(x[o], x[o + 1]); w.y = pkh2(x[o + 2], x[o + 3]); w.z = pkh2(x[o + 4], x[o + 5]); w.w = pkh2(x[o + 6], x[o + 7]); return w; }
DI v4u packt(const f32x4& a, const f32x4& b) { v4u p; p.x = pkh2(a[0], a[1]); p.y = pkh2(a[2], a[3]); p.z = pkh2(b[0], b[1]); p.w = pkh2(b[2], b[3]); return p; }
DI void wt16(__amdgpu_buffer_rsrc_t r, int off, v4u v) { __builtin_amdgcn_raw_buffer_store_b128(v, r, off, 0, 16); }
DI void wt8(__amdgpu_buffer_rsrc_t r, int off, v2u v) { __builtin_amdgcn_raw_buffer_store_b64(v, r, off, 0, 16); }
DI v4u ld16(__amdgpu_buffer_rsrc_t r, int off) { return __builtin_amdgcn_raw_buffer_load_b128(r, off, 0, 16); }
template <int ROLE>
DI void chunkA_unit(int lane, int chain, int chunk, const unsigned char* a3, __amdgpu_buffer_rsrc_t fdst, LAS unsigned char* sc,
                        const float* w0, const float* a0, const float* k_a, const float* r_k, float* bonus, v4u (&A1P)[3][2], LAS unsigned char* park, LAS unsigned char* park2) {
    asm volatile("" : "+v"(lane));
    const size_t row0 = ((size_t)chain * SEQ + (size_t)chunk * CH_L) * 64;
    const int q = lane >> 4, n = lane & 15;
    float z[16];
    float g7, g15;
    {
#pragma unroll
        for (int pl = 0; pl < 6; ++pl)
#pragma unroll
            for (int hf = 0; hf < 2; ++hf)
                if (pl != PL_V) __builtin_amdgcn_global_load_lds((const unsigned*)(a3 + (size_t)pl * PLANE + row0 * 2 + hf * 1024 + lane * 16), (LAS unsigned*)(sc + pl * 2048 + hf * 1024), 16, 0, 0);
        asm volatile("s_waitcnt vmcnt(0)" ::: "memory");
        const int cg = (chain & (NH - 1)) * 64 + lane;
        const float pw0 = w0[cg], pa0 = a0[cg], pka = k_a[cg], prk = r_k[cg];
        float gi[16], fk[16];
        { float g = 1.f;
#pragma unroll
          for (int i = 0; i < 16; ++i) { g *= __expf(-0.6065306597f * sigmoid_r(pw0 + (float)*(const LAS f16*)(sc + PL_W * 2048 + i * 128 + lane * 2))); gi[i] = g; } }
        asm volatile("" ::: "memory");
        g7 = gi[7]; g15 = gi[15];
        const float ig7 = rcpf_(g7);
        v4u agp[2], app[2], bgp[2];
#pragma unroll
        for (int h = 0; h < 2; ++h) {
            float ag[8], ap[8], bg[8];
#pragma unroll
            for (int j = 0; j < 8; ++j) { const int i = 8 * h + j;
                const float kkx = (float)*(const LAS f16*)(sc + PL_KK * 2048 + i * 128 + lane * 2), a = sigmoid_r(pa0 + (float)*(const LAS f16*)(sc + PL_B * 2048 + i * 128 + lane * 2));
                fk[i] = 1.0f + (a - 1.0f) * pka;
                const float bx = kkx * a, gp = i ? gi[i - 1] : 1.0f, ig = rcpf_(gi[i]);
                ap[j] = -kkx * gp; ag[j] = ap[j] * ig7; bg[j] = bx * (g7 * ig); z[i] = bx * (g15 * ig); }
            agp[h].x = pkh2(ag[0], ag[1]); agp[h].y = pkh2(ag[2], ag[3]); agp[h].z = pkh2(ag[4], ag[5]); agp[h].w = pkh2(ag[6], ag[7]);
            app[h].x = pkh2(ap[0], ap[1]); app[h].y = pkh2(ap[2], ap[3]); app[h].z = pkh2(ap[4], ap[5]); app[h].w = pkh2(ap[6], ap[7]);
            bgp[h].x = pkh2(bg[0], bg[1]); bgp[h].y = pkh2(bg[2], bg[3]); bgp[h].z = pkh2(bg[4], bg[5]); bgp[h].w = pkh2(bg[6], bg[7]);
            asm volatile("" ::: "memory");
        }
        float kv[16], rv[16];
#pragma unroll
        for (int i = 0; i < 16; ++i) { kv[i] = (float)*(const LAS f16*)(sc + PL_K * 2048 + i * 128 + lane * 2); rv[i] = (float)*(const LAS f16*)(sc + PL_R * 2048 + i * 128 + lane * 2); }
        asm volatile("s_waitcnt lgkmcnt(0)" ::: "memory");
        *(LAS v4u*)(sc + SC_AG + lane * 32) = agp[0]; *(LAS v4u*)(sc + SC_AG + lane * 32 + 16) = agp[1];
        *(LAS v4u*)(sc + SC_AP + lane * 32) = app[0]; *(LAS v4u*)(sc + SC_AP + lane * 32 + 16) = app[1];
        *(LAS v4u*)(sc + SC_BG + lane * 32) = bgp[0]; *(LAS v4u*)(sc + SC_BG + lane * 32 + 16) = bgp[1];
#pragma unroll
        for (int i = 0; i < 16; ++i) { rv[i] = rv[i] * gi[i] * ig7; kv[i] = kv[i] * fk[i] * (g7 * rcpf_(gi[i])); }
        *(LAS v4u*)(sc + SC_RG + lane * 32) = pack16h(rv, 0); *(LAS v4u*)(sc + SC_RG + lane * 32 + 16) = pack16h(rv, 8);
        *(LAS v4u*)(sc + SC_KG + lane * 32) = pack16h(kv, 0); *(LAS v4u*)(sc + SC_KG + lane * 32 + 16) = pack16h(kv, 8);
#pragma unroll
        for (int i = 0; i < 16; ++i) rv[i] *= prk;
        *(LAS v4u*)(sc + SC_ZT + lane * 32) = pack16h(rv, 0); *(LAS v4u*)(sc + SC_ZT + lane * 32 + 16) = pack16h(rv, 8);
    }
    asm volatile("s_waitcnt lgkmcnt(0)" ::: "memory");
    const unsigned sb = (unsigned)(size_t)sc;
    {
        f32x4 gab = {0.f, 0.f, 0.f, 0.f}, gak = gab, grb = gab, grk = gab, gbn = gab;
#pragma unroll
        for (int s2 = 0; s2 < 2; ++s2) {
            const int k0 = 32 * s2 + 8 * q;
            h16x8 fa, fr, fb, fk; tr_frag4(sb + SC_AG, k0, n, fa, fr, fb, fk);
            gab = MFMA16H(fb, fa, gab);
            gak = MFMA16H(fk, fa, gak);
            grb = MFMA16H(fr, fb, grb);
            grk = MFMA16H(fr, fk, grk);
            { const unsigned zb = sb + SC_ZT + (unsigned)(k0 + (n >> 2)) * 32u + 8u * (n & 3); s16x4 bl, bh;
              asm volatile("ds_read_b64_tr_b16 %0, %2\n\tds_read_b64_tr_b16 %1, %2 offset:128\n\ts_waitcnt lgkmcnt(0)" : "=&v"(bl), "=&v"(bh) : "v"(zb) : "memory");
              gbn = MFMA16H(__builtin_bit_cast(h16x8, __builtin_shufflevector(bl, bh, 0, 1, 2, 3, 4, 5, 6, 7)), fk, gbn); }
        }
        if ((n >> 2) == q) bonus[(size_t)chain * SEQ + (size_t)chunk * CH_L + n] = gbn[n & 3];
#pragma unroll
        for (int r4 = 0; r4 < 4; ++r4) { const int rr = 4 * q + r4;
            *(LAS float*)(sc + SC_ABT + (rr * 16 + n) * 4) = (n > rr) ? gab[r4] : 0.f;
            *(LAS f16*)(sc + SC_AK + (rr * 16 + n) * 2) = (f16)((n > rr) ? gak[r4] : 0.f);
            *(LAS float*)(sc + SC_RB + (rr * 16 + n) * 4) = (n <= rr) ? grb[r4] : 0.f;
            *(LAS float*)(sc + SC_RK + (rr * 16 + n) * 4) = (n <= rr) ? grk[r4] : 0.f; }
        *(LAS float*)(sc + SC_AG + lane * 4) = g7; *(LAS float*)(sc + SC_AG + 256 + lane * 4) = g15; *(LAS float*)(sc + SC_AG + 512 + lane * 4) = g15 * rcpf_(g7);
    }
    asm volatile("s_waitcnt lgkmcnt(0)" ::: "memory");
    {
        float wv[16];
#pragma unroll
        for (int i4 = 0; i4 < 4; ++i4) { const f32x4 t4 = *(const LAS f32x4*)(sc + SC_RB + (n * 16 + 4 * i4) * 4); wv[4 * i4] = t4[0]; wv[4 * i4 + 1] = t4[1]; wv[4 * i4 + 2] = t4[2]; wv[4 * i4 + 3] = t4[3]; }
#pragma unroll
        for (int i = 14; i >= 0; --i) {
            if (ROLE == 1 && (i % 4) == 2) asm volatile("" ::: "memory");
            float c[16];
#pragma unroll
            for (int j4 = (i + 1) / 4; j4 < 4; ++j4) { const f32x4 t4 = *(const LAS f32x4*)(sc + SC_ABT + (i * 16 + 4 * j4) * 4); c[4 * j4] = t4[0]; c[4 * j4 + 1] = t4[1]; c[4 * j4 + 2] = t4[2]; c[4 * j4 + 3] = t4[3]; }
#pragma unroll
            for (int j = i + 1; j < 16; ++j) { z[i] = __builtin_fmaf(c[j], z[j], z[i]); wv[i] = __builtin_fmaf(c[j], wv[j], wv[i]); }
        }
        *(LAS v4u*)(sc + SC_ZT + lane * 32) = pack16h(z, 0); *(LAS v4u*)(sc + SC_ZT + lane * 32 + 16) = pack16h(z, 8);
        if (lane < 16) { *(LAS v4u*)(sc + SC_WT + lane * 32) = pack16h(wv, 0); *(LAS v4u*)(sc + SC_WT + lane * 32 + 16) = pack16h(wv, 8); }
    }
    asm volatile("s_waitcnt lgkmcnt(0)" ::: "memory");
    {
        const v4u zero4 = {0u, 0u, 0u, 0u};
        h16x8 apF[4], zF[4], wF, akF;
#pragma unroll
        for (int m4 = 0; m4 < 4; ++m4) {
            apF[m4] = __builtin_bit_cast(h16x8, q < 2 ? *(const LAS v4u*)(sc + SC_AP + (16 * m4 + n) * 32 + 16 * q) : zero4);
            zF[m4] = __builtin_bit_cast(h16x8, q < 2 ? *(const LAS v4u*)(sc + SC_ZT + (16 * m4 + n) * 32 + 16 * q) : zero4); }
        wF = __builtin_bit_cast(h16x8, q < 2 ? *(const LAS v4u*)(sc + SC_WT + n * 32 + 16 * q) : zero4);
        akF = __builtin_bit_cast(h16x8, q < 2 ? *(const LAS v4u*)(sc + SC_AK + n * 32 + 16 * q) : zero4);
        const f32x4 z4 = {0.f, 0.f, 0.f, 0.f};
        f32x4 py[4];
#pragma unroll
        for (int m4 = 0; m4 < 4; ++m4) { f32x4 init;
#pragma unroll
            for (int r4 = 0; r4 < 4; ++r4) { const int kc = 16 * m4 + 4 * q + r4; init[r4] = (float)*(const LAS f16*)(sc + SC_RG + kc * 32 + n * 2) * *(const LAS float*)(sc + SC_AG + kc * 4); }
            py[m4] = MFMA16H(apF[m4], wF, init); }
        f32x4 qy = *(const LAS f32x4*)(sc + SC_RK + (n * 16 + 4 * q) * 4);
        qy = MFMA16H(akF, wF, qy);
        if constexpr (ROLE == 0) {
            wt16(fdst, 12 * 1024 + lane * 16, packt(py[0], py[1])); wt16(fdst, 13 * 1024 + lane * 16, packt(py[2], py[3]));
            { v4u o; o.x = pkh2(qy[0], qy[1]); o.y = pkh2(qy[2], qy[3]); o.z = 0u; o.w = 0u; wt16(fdst, 14 * 1024 + lane * 16, o); }
#pragma unroll
            for (int nt = 0; nt < 4; ++nt) {
                const float g15c = *(const LAS float*)(sc + SC_AG + 256 + (16 * nt + n) * 4);
                f32x4 t[4];
#pragma unroll
                for (int mt = 0; mt < 4; ++mt) { f32x4 init = z4;
                    if (mt == nt) {
#pragma unroll
                        for (int r4 = 0; r4 < 4; ++r4) init[r4] = (4 * q + r4 == n) ? g15c : 0.f; }
                    t[mt] = MFMA16H(zF[mt], apF[nt], init); }
                if (nt < 3) { A1P[nt][0] = packt(t[0], t[1]); A1P[nt][1] = packt(t[2], t[3]); } else { *(LAS v4u*)(park2 + lane * 16) = packt(t[0], t[1]); *(LAS v4u*)(park2 + 1024 + lane * 16) = packt(t[2], t[3]); }
            }
            f32x4 qt[4];
#pragma unroll
            for (int mt = 0; mt < 4; ++mt) { f32x4 init;
#pragma unroll
                for (int r4 = 0; r4 < 4; ++r4) { const int kc = 16 * mt + 4 * q + r4; init[r4] = (float)*(const LAS f16*)(sc + SC_KG + kc * 32 + n * 2) * *(const LAS float*)(sc + SC_AG + 512 + kc * 4); }
                qt[mt] = MFMA16H(zF[mt], akF, init); }
            *(LAS v4u*)(park + lane * 16) = packt(qt[0], qt[1]); *(LAS v4u*)(park + 1024 + lane * 16) = packt(qt[2], qt[3]);
        } else {
            { const h16x8 b0 = __builtin_bit_cast(h16x8, packt(py[0], py[1])), b1 = __builtin_bit_cast(h16x8, packt(py[2], py[3]));
              f32x4 pp[4];
#pragma unroll
              for (int nt = 0; nt < 4; ++nt) { pp[nt] = MFMA16H(__builtin_bit_cast(h16x8, nt < 3 ? A1P[nt][0] : *(const LAS v4u*)(park2 + lane * 16)), b0, z4); pp[nt] = MFMA16H(__builtin_bit_cast(h16x8, nt < 3 ? A1P[nt][1] : *(const LAS v4u*)(park2 + 1024 + lane * 16)), b1, pp[nt]); }
              f32x4 qp = MFMA16H(__builtin_bit_cast(h16x8, *(const LAS v4u*)(park + lane * 16)), b0, z4); qp = MFMA16H(__builtin_bit_cast(h16x8, *(const LAS v4u*)(park + 1024 + lane * 16)), b1, qp);
              wt16(fdst, 15 * 1024 + lane * 16, packt(pp[0], pp[1])); wt16(fdst, 16 * 1024 + lane * 16, packt(pp[2], pp[3]));
              wt16(fdst, 17 * 1024 + lane * 16, packt(qp, qy)); }
#pragma unroll
            for (int mt = 0; mt < 4; ++mt) {
                const float g15c = *(const LAS float*)(sc + SC_AG + 256 + (16 * mt + n) * 4), rat = *(const LAS float*)(sc + SC_AG + 512 + (16 * mt + n) * 4);
                f32x4 ps[4];
#pragma unroll
                for (int m4 = 0; m4 < 4; ++m4) { f32x4 init = z4;
                    if (m4 == mt) {
#pragma unroll
                        for (int r4 = 0; r4 < 4; ++r4) init[r4] = (4 * q + r4 == n) ? g15c : 0.f; }
                    ps[m4] = MFMA16H(apF[m4], zF[mt], init); }
                const h16x8 b0 = __builtin_bit_cast(h16x8, packt(ps[0], ps[1])), b1 = __builtin_bit_cast(h16x8, packt(ps[2], ps[3]));
                f32x4 pp[4];
#pragma unroll
                for (int nt = 0; nt < 4; ++nt) { pp[nt] = MFMA16H(__builtin_bit_cast(h16x8, nt < 3 ? A1P[nt][0] : *(const LAS v4u*)(park2 + lane * 16)), b0, z4); pp[nt] = MFMA16H(__builtin_bit_cast(h16x8, nt < 3 ? A1P[nt][1] : *(const LAS v4u*)(park2 + 1024 + lane * 16)), b1, pp[nt]); }
                f32x4 qp = MFMA16H(__builtin_bit_cast(h16x8, *(const LAS v4u*)(park + lane * 16)), b0, z4); qp = MFMA16H(__builtin_bit_cast(h16x8, *(const LAS v4u*)(park + 1024 + lane * 16)), b1, qp);
                f32x4 qs; { const v2u kh = *(const LAS v2u*)(sc + SC_KG + (16 * mt + n) * 32 + 8 * q); qs[0] = hlo(kh.x) * rat; qs[1] = hhi(kh.x) * rat; qs[2] = hlo(kh.y) * rat; qs[3] = hhi(kh.y) * rat; }
                qs = MFMA16H(akF, zF[mt], qs);
                wt16(fdst, (mt * 3 + 0) * 1024 + lane * 16, packt(pp[0], pp[1])); wt16(fdst, (mt * 3 + 1) * 1024 + lane * 16, packt(pp[2], pp[3]));
                wt16(fdst, (mt * 3 + 2) * 1024 + lane * 16, packt(qp, qs));
            }
        }
    }
    asm volatile("s_waitcnt lgkmcnt(0)" ::: "memory");
}
constexpr int PRB = 18432, LBB = 24576, NPAIR = CH_SEGCH / 2;
constexpr int ATT_CH = 1;
constexpr int NFB = 8;
constexpr size_t SEG_BYTES = (size_t)NCHAIN * NPAIR * PRB;
DI void chunkB_issue(v4u (&f)[18], v2u& vlo, v2u& vhi, unsigned la, unsigned lv) {
#pragma unroll
    for (int i = 0; i < 18; ++i) asm volatile("ds_read_b128 %0, %1 offset:%2" : "=v"(f[i]) : "v"(la), "n"(i * 1024) : "memory");
    asm volatile("ds_read_b64_tr_b16 %0, %1 offset:18432" : "=v"(vlo) : "v"(lv) : "memory");
    asm volatile("ds_read_b64_tr_b16 %0, %1 offset:20480" : "=v"(vhi) : "v"(lv) : "memory");
}
DI void chunkB_landed(v4u (&f)[18], v2u& vlo, v2u& vhi) {
    asm volatile("s_waitcnt lgkmcnt(0)" : "+v"(f[0]), "+v"(f[1]), "+v"(f[2]), "+v"(f[3]), "+v"(f[4]), "+v"(f[5]), "+v"(f[6]), "+v"(f[7]), "+v"(f[8]), "+v"(f[9]),
                 "+v"(f[10]), "+v"(f[11]), "+v"(f[12]), "+v"(f[13]), "+v"(f[14]), "+v"(f[15]), "+v"(f[16]), "+v"(f[17]), "+v"(vlo), "+v"(vhi) :: "memory");
}
DI void chunkB_pair(const v4u (&f)[18], const v2u& vlo, const v2u& vhi, f32x4 (&Cst)[4], GAS bf16* yp) {
    h16x8 bs0, bs1;
    { v4u p; p.x = pkh2(Cst[0][0], Cst[0][1]); p.y = pkh2(Cst[0][2], Cst[0][3]); p.z = pkh2(Cst[1][0], Cst[1][1]); p.w = pkh2(Cst[1][2], Cst[1][3]); bs0 = __builtin_bit_cast(h16x8, p); }
    { v4u p; p.x = pkh2(Cst[2][0], Cst[2][1]); p.y = pkh2(Cst[2][2], Cst[2][3]); p.z = pkh2(Cst[3][0], Cst[3][1]); p.w = pkh2(Cst[3][2], Cst[3][3]); bs1 = __builtin_bit_cast(h16x8, p); }
    h16x8 bv; { v4u p; p.x = vlo.x; p.y = vlo.y; p.z = vhi.x; p.w = vhi.y; bv = __builtin_bit_cast(h16x8, p); }
    const f32x4 z4 = {0.f, 0.f, 0.f, 0.f};
    f32x4 acc[6];
#pragma unroll
    for (int mt = 0; mt < 6; ++mt) {
        acc[mt] = MFMA16H(__builtin_bit_cast(h16x8, f[mt * 3 + 0]), bs0, z4);
        acc[mt] = MFMA16H(__builtin_bit_cast(h16x8, f[mt * 3 + 1]), bs1, acc[mt]);
        acc[mt] = MFMA16H(__builtin_bit_cast(h16x8, f[mt * 3 + 2]), bv, acc[mt]); }
#pragma unroll
    for (int mt = 0; mt < 4; ++mt) Cst[mt] = acc[mt];
    v2u y1, y2; y1.x = cvt_pk_bf16_c(acc[4][0], acc[4][1]); y1.y = cvt_pk_bf16_c(acc[4][2], acc[4][3]); y2.x = cvt_pk_bf16_c(acc[5][0], acc[5][1]); y2.y = cvt_pk_bf16_c(acc[5][2], acc[5][3]);
    *(GAS v2u*)yp = y1; *(GAS v2u*)(yp + 4 * 64 * 4) = y2;
}
constexpr int SD = 8, NPC = CH_NSEG * NPAIR;
DI void chunkB_chain(const Frame& F, int chain, const unsigned char* sfrag, unsigned char* a2, unsigned* hw, unsigned* bar) {
    const int lane = F.lane;
    LAS unsigned char* lbuf = F.lds;
    if (F.wave < 4) {
        const int vt = F.wave, q = lane >> 4, n = lane & 15;
        GAS bf16* Y = (GAS bf16*)(a2 + A2_Y) + (((size_t)chain * (SEQ / 4) + q) * 64 + 16 * vt + n) * 4;
        f32x4 Cst[4];
#pragma unroll
        for (int i = 0; i < 4; ++i) Cst[i] = (f32x4){0.f, 0.f, 0.f, 0.f};
        const unsigned la0 = (unsigned)(size_t)lbuf + lane * 16, lv0 = (unsigned)(size_t)lbuf + (4 * q + (n >> 2)) * 128 + (16 * vt + 4 * (n & 3)) * 2;
        v4u fA[18], fB[18]; v2u aL, aH, bL, bH;
        __builtin_amdgcn_s_barrier(); asm volatile("" ::: "memory");
        chunkB_issue(fA, aL, aH, la0, lv0);
#pragma unroll 1
        for (int p = 0; p < NPC; p += 2) {
            chunkB_landed(fA, aL, aH);
            __builtin_amdgcn_s_barrier(); asm volatile("" ::: "memory");
            chunkB_issue(fB, bL, bH, la0 + LBB, lv0 + LBB);
            chunkB_pair(fA, aL, aH, Cst, Y + (size_t)p * 2 * 4 * 64 * 4);
            chunkB_landed(fB, bL, bH);
            __builtin_amdgcn_s_barrier(); asm volatile("" ::: "memory");
            if (p + 2 < NPC) chunkB_issue(fA, aL, aH, la0, lv0);
            chunkB_pair(fB, bL, bH, Cst, Y + (size_t)(p + 1) * 2 * 4 * 64 * 4);
            if (((p + 1) & (NPAIR - 1)) == NPAIR - 1 && F.tid == 0) __hip_atomic_store(hw + CW_SDONE + (((p + 1) >> 6) * NCHAIN + chain) * 64, 1u, __ATOMIC_RELAXED, __HIP_MEMORY_SCOPE_AGENT);
        }
    } else {
        const int hwv = F.wave - 4;
        const __amdgpu_buffer_rsrc_t rs = __builtin_amdgcn_make_buffer_rsrc(const_cast<unsigned char*>(sfrag) - WS_SFRAG, 0, (int)WS_END, 0x00020000);
        const int voff = lane * 16;
        LAS unsigned char* ldst = lbuf + hwv * 6 * 1024 + lane * 16;
        v4u r[SD][6];
        auto LD = [&](int Pq, v4u (&rr)[6]) {
            const int P = Pq < NPC ? Pq : NPC - 1, seg = P >> 6;
            if (Pq < NPC && (P & (NPAIR - 1)) == 0) {
                const unsigned* cw = hw + (seg * NCHAIN + chain) * 64; unsigned sp = 0u, v;
                do { asm volatile("global_load_dword %0, %1, off sc1\n\ts_waitcnt vmcnt(0)" : "=v"(v) : "v"(cw) : "memory"); if ((unsigned)__builtin_amdgcn_readfirstlane(v) >= (unsigned)NPAIR) break; __builtin_amdgcn_s_sleep(1); } while (++sp < XB_SPIN_CAP);
                asm volatile("buffer_inv sc1" ::: "memory"); }
            const unsigned fo = (unsigned)WS_SFRAG + (unsigned)(seg % NFB) * (unsigned)SEG_BYTES + (unsigned)(chain * NPAIR + (P & (NPAIR - 1))) * PRB;
            const unsigned vo = (unsigned)(WS_A3 + (size_t)PL_V * PLANE) + (unsigned)(chain * (SEQ / 32) + P) * 4096u;
#pragma unroll
            for (int j = 0; j < 6; ++j) { const int sl = hwv * 6 + j;
                const unsigned so = sl < 18 ? fo + sl * 1024 : vo + (sl < 22 ? sl - 18 : 3) * 1024;
                rr[j] = __builtin_amdgcn_raw_buffer_load_b128(rs, voff, so, 0); }
        };
        auto WR = [&](int P, const v4u (&rr)[6]) {
            if (P < NPC) {
                LAS unsigned char* d = ldst + (P & 1) * LBB;
#pragma unroll
                for (int j = 0; j < 6; ++j) *(LAS v4u*)(d + j * 1024) = rr[j];
            }
        };
#pragma unroll
        for (int k = 0; k < SD; ++k) LD(k, r[k]);
        WR(0, r[0]); LD(SD, r[0]); WR(1, r[1]); LD(SD + 1, r[1]);
        asm volatile("s_waitcnt lgkmcnt(0)" ::: "memory"); __builtin_amdgcn_s_barrier(); asm volatile("" ::: "memory");
#pragma unroll 1
        for (int g = 0; g < NPC; g += SD) {
#pragma unroll
            for (int k = 0; k < SD; ++k) {
                __builtin_amdgcn_s_barrier(); asm volatile("" ::: "memory");
                WR(g + k + 2, r[(k + 2) % SD]); LD(g + k + 2 + SD, r[(k + 2) % SD]);
                asm volatile("s_waitcnt lgkmcnt(0)" ::: "memory");
            }
        }
    }
    asm volatile("s_waitcnt vmcnt(0) lgkmcnt(0)" ::: "memory"); __builtin_amdgcn_s_barrier(); asm volatile("" ::: "memory");
}

#define MFMA32(a, b, c) __builtin_amdgcn_mfma_f32_32x32x16_bf16((a), (b), (c), 0, 0, 0)
DI int crow(int reg, int h) { return (reg & 3) + 8 * (reg >> 2) + 4 * h; }
DI s16x4 tr_read(unsigned lds_addr) { s16x4 r; asm volatile("ds_read_b64_tr_b16 %0, %1\n\ts_waitcnt lgkmcnt(0)" : "=&v"(r) : "v"(lds_addr) : "memory"); return r; }
DI bf16x8 pack_step(const f32x16& x, int s) {
    v4u p;
    asm volatile("s_nop 1\n\tv_cvt_pk_bf16_f32 %0, %4, %5\n\tv_cvt_pk_bf16_f32 %1, %6, %7\n\tv_cvt_pk_bf16_f32 %2, %8, %9\n\tv_cvt_pk_bf16_f32 %3, %10, %11\n\ts_nop 1"
                 : "=&v"(p[0]), "=&v"(p[1]), "=&v"(p[2]), "=&v"(p[3])
                 : "v"(x[8 * s]), "v"(x[8 * s + 1]), "v"(x[8 * s + 2]), "v"(x[8 * s + 3]), "v"(x[8 * s + 4]), "v"(x[8 * s + 5]), "v"(x[8 * s + 6]), "v"(x[8 * s + 7]));
    return __builtin_bit_cast(bf16x8, p);
}
constexpr int VPITCH = 192;
DI void attn_unit(const Frame& F, int unit, unsigned char* a2, const float* sinks) {
    const int lane = F.lane, w = F.wave, r = lane & 31, h = lane >> 5;
    const int b = unit >> 10, kvh = (unit >> 8) & 3, q0 = (unit & 255) * 64;
    const bf16* Q = (const bf16*)(a2 + A2_Q); const bf16* Kp = (const bf16*)(a2 + A2_K); const bf16* Vp = (const bf16*)(a2 + A2_V);
    bf16* O = (bf16*)(a2 + A2_COUT);
    LAS unsigned char* vl = F.lds;
#pragma unroll
    for (int i = 0; i < 3; ++i) { const int c = F.tid + 512 * i, row = c >> 3, pc = c & 7; int kp = q0 - 128 + row; kp = kp < 0 ? 0 : kp;
        const v4u v = *(const GAS v4u*)(Vp + (size_t)(b * SEQ + kp) * 256 + kvh * 64 + pc * 8);
        *(LAS v4u*)(vl + row * VPITCH + pc * 16) = v; }
    const int g = w >> 1, half = w & 1, qh = kvh * 4 + g;
    const int qa = q0 + 32 * half + r;
    bf16x8 qf[4];
#pragma unroll
    for (int s = 0; s < 4; ++s) qf[s] = *(const GAS bf16x8*)(Q + (size_t)(b * SEQ + qa) * C + qh * 64 + 16 * s + 8 * h);
    f32x16 st[5];
    const float sink = sinks[qh];
    float mx = sink;
#pragma unroll
    for (int i = 0; i < 5; ++i) {
        const int kb = q0 - 128 + 32 * (half + i);
        int kr = kb + r; kr = kr < 0 ? 0 : kr;
        bf16x8 kf[4];
#pragma unroll
        for (int s = 0; s < 4; ++s) kf[s] = *(const GAS bf16x8*)(Kp + (size_t)(b * SEQ + kr) * 256 + kvh * 64 + 16 * s + 8 * h);
        f32x16 a;
#pragma unroll
        for (int j = 0; j < 16; ++j) a[j] = 0.f;
#pragma unroll
        for (int s = 0; s < 4; ++s) a = MFMA32(kf[s], qf[s], a);
#pragma unroll
        for (int j = 0; j < 16; ++j) { const int kp = kb + crow(j, h); const bool ok = (kp >= 0) && (kp <= qa) && (kp > qa - 128);
            const float sv = ok ? a[j] * 0.125f : -INFINITY; a[j] = sv; mx = fmaxf(mx, sv); }
        st[i] = a;
    }
    mx = fmaxf(mx, __shfl_xor(mx, 32));
    float l = 0.f;
#pragma unroll
    for (int i = 0; i < 5; ++i)
#pragma unroll
        for (int j = 0; j < 16; ++j) { const float e = __expf(st[i][j] - mx); st[i][j] = e; l += e; }
    l += __shfl_xor(l, 32);
    l += __expf(sink - mx);
    const float inv = 1.0f / l;
    __syncthreads();
    f32x16 ot[2];
#pragma unroll
    for (int db = 0; db < 2; ++db)
#pragma unroll
        for (int j = 0; j < 16; ++j) ot[db][j] = 0.f;
    const unsigned vbase = (unsigned)(size_t)vl;
    const int i16 = lane & 15, q4 = i16 >> 2, p4 = i16 & 3, blk = (lane >> 4) & 1;
#pragma unroll
    for (int i = 0; i < 5; ++i) {
        const int trow = 32 * (half + i);
#pragma unroll
        for (int s = 0; s < 2; ++s) {
            const bf16x8 pb = pack_step(st[i], s);
#pragma unroll
            for (int db = 0; db < 2; ++db) {
                const unsigned cb = (unsigned)((db * 32 + 16 * blk) * 2 + 8 * p4);
                const s16x4 lo = tr_read(vbase + (unsigned)(trow + 16 * s + 4 * h + q4) * VPITCH + cb);
                const s16x4 hi = tr_read(vbase + (unsigned)(trow + 16 * s + 8 + 4 * h + q4) * VPITCH + cb);
                const bf16x8 va = __builtin_shufflevector(lo, hi, 0, 1, 2, 3, 4, 5, 6, 7);
                ot[db] = MFMA32(va, pb, ot[db]);
            }
        }
    }
    bf16* orow = O + (size_t)(b * SEQ + qa) * C + qh * 64;
#pragma unroll
    for (int db = 0; db < 2; ++db)
#pragma unroll
        for (int q = 0; q < 4; ++q) { v2u wv; wv.x = pk2(ot[db][4 * q] * inv, ot[db][4 * q + 1] * inv); wv.y = pk2(ot[db][4 * q + 2] * inv, ot[db][4 * q + 3] * inv);
            *(GAS v2u*)(orow + 32 * db + 8 * q + 4 * h) = wv; }
    __syncthreads();
}

DI void route_tokens(const Frame& F, int layer, const float* logits, const float* bg, const float* be, unsigned* cnt, int* list, float* tg) {
    LAS int* lcnt = (LAS int*)(F.lds);
    LAS int* lbase = lcnt + 32;
#pragma unroll 1
    for (int blk = F.bid; blk < NT / 128; blk += F.G) {
        if (F.tid < 64) lcnt[F.tid] = 0;
        __syncthreads();
        const int tok = blk * 128 + F.tid;
        const bool act = F.tid < 128;
        int e0 = 0, e1 = 0, p0 = 0, p1 = 0; float g0 = 0.f, g1 = 0.f;
        if (act) {
            const float* lg = logits + (size_t)tok * 64;
            float gl[4]; int grp = 0; float gm = -INFINITY;
#pragma unroll
            for (int j = 0; j < 4; ++j) { gl[j] = lg[j] + bg[j]; if (gl[j] > gm) { gm = gl[j]; grp = j; } }
            float gs = 0.f;
#pragma unroll
            for (int j = 0; j < 4; ++j) gs += __expf(gl[j] - gm);
            const float pgrp = 1.0f / gs;
            int i0 = 0; float v0 = -INFINITY; int i1 = 0; float v1 = -INFINITY;
#pragma unroll
            for (int j = 0; j < 8; ++j) { const float el = lg[4 + grp * 8 + j] + be[grp * 8 + j];
                if (el > v0) { v1 = v0; i1 = i0; v0 = el; i0 = j; } else if (el > v1) { v1 = el; i1 = j; } }
            const float x1 = __expf(v1 - v0);
            g0 = pgrp / (1.0f + x1); g1 = pgrp * x1 / (1.0f + x1);
            e0 = grp * 8 + i0; e1 = grp * 8 + i1;
            p0 = atomicAdd((int*)&lcnt[e0], 1); p1 = atomicAdd((int*)&lcnt[e1], 1);
        }
        __syncthreads();
        if (F.tid < 32) { const int c = lcnt[F.tid]; lbase[F.tid] = c ? (int)atomicAdd(cnt + layer * 32 + F.tid, (unsigned)c) : 0; }
        __syncthreads();
        if (act) {
            list[(size_t)e0 * NT + lbase[e0] + p0] = tok * 2; list[(size_t)e1 * NT + lbase[e1] + p1] = tok * 2 + 1;
            tg[2 * tok] = g0; tg[2 * tok + 1] = g1;
        }
        __syncthreads();
    }
}
DI int moe_tables(const Frame& F, int layer, const unsigned* cnt, const int* list, int ncol, bool down, LAS int* rb2e, LAS int* rows) {
    LAS int* scnt = rb2e + 320; LAS int* sstart = scnt + 32;
    if (F.tid == 0) { int acc = 0;
#pragma unroll 1
        for (int e = 0; e < NEXP; ++e) { const int c = (int)__hip_atomic_load((unsigned*)cnt + layer * 32 + e, RLX_AGENT); scnt[e] = c; sstart[e] = acc; const int nb = (c + 255) >> 8;
#pragma unroll 1
            for (int j = 0; j < nb; ++j) rb2e[acc + j] = e;
            acc += nb; } sstart[NEXP] = acc; }
    __syncthreads();
    const int RB = __builtin_amdgcn_readfirstlane(sstart[NEXP]), total = RB * ncol;
#pragma unroll 1
    for (int ui = 0; ; ++ui) {
        const long L = (long)ui * F.G + F.bid; if (L >= total) break;
        const int rb = (int)(L / ncol), e = rb2e[rb], lb = rb - sstart[e];
        if (F.tid < 256) { const int idx = lb * 256 + F.tid; int v;
            if (idx < scnt[e]) { const int ent = list[(size_t)e * NT + idx]; v = down ? ent : (ent >> 1); } else v = down ? -1 : 0;
            rows[ui * 256 + F.tid] = v; }
    }
    __syncthreads();
    return RB;
}

DI const void* in_ptr(const Args& args, int idx) { asm volatile("" : "+s"(idx)); return args.in[idx]; }
template <int PLO, int PHI> __global__ void __launch_bounds__(NWAVES * 64, 2) mega_fwd(Args args) {
    extern __shared__ __attribute__((aligned(16))) unsigned char lds_raw[];
    Frame F0;
    F0.lds = (LAS unsigned char*)lds_raw; F0.ws = args.ws;
    F0.tid = threadIdx.x; F0.lane = F0.tid & 63; F0.wave = __builtin_amdgcn_readfirstlane(F0.tid >> 6);
    F0.G = gridDim.x; F0.bid = blockIdx.x; F0.gw = F0.bid * NWAVES + F0.wave; F0.NGW = F0.G * NWAVES;
    float* out = args.out;
    volatile LAS unsigned* MISC = (volatile LAS unsigned*)(F0.lds + MISC_OFF);
    if (F0.tid < 32) MISC[F0.tid] = 0u;
    __syncthreads();
#if MK_ONE_LAUNCH
    XcdBarrier bar = xcd_barrier_post((unsigned*)(args.ws + WS_CTL) + CW_BAR, MISC + 8);
#define GRID_BAR() xcd_barrier(bar)
#else
#define GRID_BAR() do {} while (0)
#endif
#define IN(k) (PLO <= (k) && (k) < PHI)
#define PHASE_BEGIN() Frame F = F0; { int t_ = F0.tid; asm volatile("" : "+v"(t_)); F.tid = t_; F.lane = t_ & 63; F.wave = __builtin_amdgcn_readfirstlane(t_ >> 6); F.gw = F.bid * NWAVES + F.wave; int g_ = F0.G; asm volatile("" : "+s"(g_)); F.G = g_; F.NGW = g_ * NWAVES; } \
        unsigned char* ws = F0.ws; asm volatile("" : "+s"(ws)); LAS unsigned char* ring = F.lds; \
        unsigned char* a2 = ws + WS_A2; unsigned char* a3 = ws + WS_A3; unsigned char* a4 = ws + WS_A4; unsigned char* wl = ws + WS_W; bf16* Hb = (bf16*)(ws + WS_H); unsigned* ctl = (unsigned*)(ws + WS_CTL); \
        bf16* WinT = (bf16*)(wl + W_WIN); bf16* WloraT = (bf16*)(wl + W_LORA); bf16* WpoolT = (bf16*)(wl + W_POOL); bf16* WbT = (bf16*)(wl + W_BR); bf16* WoT = (bf16*)(wl + W_WO); bf16* WrT = (bf16*)(wl + W_RT); \
        float* logits = (float*)(ws + WS_LOG); int* list = (int*)(ws + WS_LIST); float* tg = (float*)(ws + WS_TG); \
        bf16* Y2 = (bf16*)(a2 + A2_Y2); bf16* HM = (bf16*)(a2 + A2_HM); bf16* W13T = (bf16*)(a3 + A3_W13); bf16* W2T = (bf16*)(a3 + A3_W2); bf16* merged = (bf16*)a4; \
        (void)a2; (void)a3; (void)a4; (void)Hb; (void)ctl; (void)WinT; (void)WloraT; (void)WpoolT; (void)WbT; (void)WoT; (void)WrT; (void)logits; (void)list; (void)tg; (void)Y2; (void)HM; (void)W13T; (void)W2T; (void)merged; (void)ring
#define INP(idx, stride) ((const float*)in_ptr(args, idx) + (size_t)layer * (stride))

#pragma unroll 1
    for (int layer = args.l_lo; layer < args.l_hi; ++layer) {
        if constexpr (IN(0)) {
            PHASE_BEGIN();
            const float* x_in = INP(I_X, 0); const float* attn_norm = INP(I_ATTN_NORM, D); const float* w_in = INP(I_WIN, (size_t)D * INC);
            const float* w_up = INP(I_WUP, 96 * C); const float* a_up = INP(I_AUP, 96 * C); const float* g_up = INP(I_GUP, 256 * C);
            const float* pool_w = INP(I_POOLW, 4 * 256 * 256); const float* pool_s = INP(I_POOLS, C);
            const float* w_br = INP(I_WBR, (size_t)3 * C * D); const float* w_out = INP(I_WOUT, (size_t)D * D);
            const float* rgw = INP(I_RGW, D * 4); const float* rew = INP(I_REW, D * 32);
            constexpr int I_IN = 32 * 382, I_BR = 3 * 16 * 64, I_WO = 32 * 64;
            auto p0_item = [&](int r, const float*& W, int& K, int& N, bf16*& WT, int& drow, int& k0, int& n0) {
                if (r < I_IN) { const int kb = r / 382, nb = r % 382; n0 = 32 * nb; W = w_in; K = D; N = INC; WT = WinT; drow = n0 + (n0 >= ZC ? 64 : 0); k0 = 64 * kb; return; } r -= I_IN;
                if (r < I_BR) { const int br = r / 1024, q = r % 1024, kb = q / 64, nb = q % 64; W = w_br + (size_t)br * C * D; K = C; N = D; WT = WbT + (size_t)br * D * C; drow = 32 * nb; k0 = 64 * kb; n0 = 32 * nb; return; } r -= I_BR;
                { const int kb = r / 64, nb = r % 64; W = w_out; K = D; N = D; WT = WoT; drow = 32 * nb; k0 = 64 * kb; n0 = 32 * nb; }
            };
#pragma unroll 1
            for (int it = F.gw; it < I_IN + I_BR + I_WO; it += 2 * F.NGW) {
                const int it1 = it + F.NGW; const bool has1 = it1 < I_IN + I_BR + I_WO;
                const float* Wa; const float* Wb2; bf16* Ta; bf16* Tb; int Ka, Na, da, ka, na, Kb, Nb, db, kb2, nb2;
                p0_item(it, Wa, Ka, Na, Ta, da, ka, na); p0_item(has1 ? it1 : it, Wb2, Kb, Nb, Tb, db, kb2, nb2);
                f32x4 va[8], vb[8];
                tr_load(va, Wa, Na, ka, na, F.lane); tr_load(vb, Wb2, Nb, kb2, nb2, F.lane);
                tr_store(va, Ta, Ka, da, ka, F.lane);
                if (has1) tr_store(vb, Tb, Kb, db, kb2, F.lane);
            }
            const int gt = F.bid * 512 + F.tid, NGT = F.G * 512;
            for (int i = gt; i < 64 * 2048 / 8; i += NGT) *(GAS v4u*)(WinT + (size_t)ZC * D + (size_t)i * 8) = (v4u){0u, 0u, 0u, 0u};
            for (int i = gt; i < 3 * 1024 * 256; i += NGT) { const int m = i >> 18, n = (i >> 8) & 1023, k = i & 255; float v = 0.f;
                if (m == 0) { if (k < 96) v = w_up[(size_t)k * C + n]; } else if (m == 1) { if (k < 96) v = a_up[(size_t)k * C + n]; } else v = g_up[(size_t)k * C + n];
                WloraT[i] = (bf16)f2bf(v); }
            for (int i = gt; i < 4 * 256 * 256; i += NGT) { const int g = i >> 16, n = (i >> 8) & 255, k = i & 255; WpoolT[i] = (bf16)f2bf(pool_w[(size_t)g * 65536 + (size_t)k * 256 + n] * pool_s[g * 256 + n]); }
            for (int i = gt; i < 256 * 2048; i += NGT) { const int n = i >> 11, k = i & 2047; float v = 0.f; if (n < 4) v = rgw[(size_t)k * 4 + n]; else if (n < 36) v = rew[(size_t)k * 32 + (n - 4)]; WrT[i] = (bf16)f2bf(v); }
            {
                const bool comb = layer > 0; const float* xsrc = comb ? out : x_in;
                if (!comb) {
#pragma unroll 1
                    for (int m = F.gw; m < NT; m += 2 * F.NGW) {
                        const int m1 = m + F.NGW; const bool has1 = m1 < NT;
                        f32x4 va[8], vb[8];
                        const GAS f32x4* xa = (const GAS f32x4*)(xsrc + (size_t)m * D) + F.lane; const GAS f32x4* xb = (const GAS f32x4*)(xsrc + (size_t)(has1 ? m1 : m) * D) + F.lane;
#pragma unroll
                        for (int j = 0; j < 8; ++j) { va[j] = xa[64 * j]; vb[j] = xb[64 * j]; }
                        rms_store(va, attn_norm, Hb + (size_t)m * D, F.lane);
                        if (has1) rms_store(vb, attn_norm, Hb + (size_t)m1 * D, F.lane);
                    }
                } else {
#pragma unroll 1
                    for (int m = F.gw; m < NT; m += F.NGW) {
                        f32x4 v[8];
                        const GAS f32x4* xr = (const GAS f32x4*)(out + (size_t)m * D) + F.lane;
#pragma unroll
                        for (int j = 0; j < 8; ++j) v[j] = xr[64 * j];
                        moe_combine(v, Y2, tg, m, F.lane);
                        GAS f32x4* xo = (GAS f32x4*)(out + (size_t)m * D) + F.lane;
#pragma unroll
                        for (int j = 0; j < 8; ++j) xo[64 * j] = v[j];
                        rms_store(v, attn_norm, Hb + (size_t)m * D, F.lane);
                    }
                }
            }
            GRID_BAR();
        }
        if constexpr (IN(1)) for (int rep_ = 0; rep_ < PROBE_REPS(1); ++rep_) {
            PHASE_BEGIN();
            DenseSched S{(const char*)Hb, (const char*)WinT, (size_t)256 * D * 2, (size_t)256 * D * 2, 128, 24, F.G, F.bid};
            EpiProj E{a2};
            pg::gemm_phase<EpiProj, DenseSched, false>(ring, D * 2, D * 2, D, S, E);
            GRID_BAR();
        }
        if constexpr (IN(2)) {
            PHASE_BEGIN();
            const float* mu = INP(I_MU, ZC); const float* k_k = INP(I_KK, C); const float* qn = INP(I_QN, HD); const float* kn = INP(I_KN, HD); const int* positions = (const int*)in_ptr(args, I_POS);
#pragma unroll 1
            for (int m = F.gw; m < NT / 16; m += F.NGW) prep_block(F, m, a2, a3, a4, mu, k_k, qn, kn, positions);
            GRID_BAR();
        }
        if constexpr (IN(3)) for (int rep_ = 0; rep_ < PROBE_REPS(3); ++rep_) {
            { PHASE_BEGIN(); LoraSched S{(const char*)(a4 + A4_LORA), (const char*)WloraT, F.G, F.bid}; EpiLora E{a2, a3};
              pg::gemm_phase<EpiLora, LoraSched, false>(ring, 1024 * 2, 256 * 2, 256, S, E); }
            { PHASE_BEGIN(); PoolSched S{(const char*)(a4 + A4_POOL), (const char*)WpoolT, F.G, F.bid}; EpiPool E{(bf16*)(a2 + A2_BOUT)};
              pg::gemm_phase<EpiPool, PoolSched, false>(ring, 1024 * 2, 256 * 2, 256, S, E); }
            GRID_BAR();
        }
        if constexpr (IN(5)) for (int rep_ = 0; rep_ < PROBE_REPS(5); ++rep_) {
            {
                {   PHASE_BEGIN();
                    const bool chainwg = F.bid < NCHAIN;
                    unsigned char* fb = ws + WS_SFRAG;
                    LAS unsigned char* sc = ring + F.wave * SC_BYTES;
                    LAS unsigned char* park = F.lds + TBL_OFF + F.wave * 4096;
                    LAS unsigned char* park2 = park + 2048;
                    const float* pw0 = INP(I_W0, C); const float* pa0 = INP(I_A0, C); const float* pk_a = INP(I_KA, C); const float* pr_k = INP(I_RK, C); float* bonus = (float*)(ws + WS_BON);
                    unsigned* hw = ctl + CW_SCAN + (size_t)(layer * 2 + rep_) * (CH_NSEG * NCHAIN * 64);
                    unsigned* bar = ctl + CW_BAR;
                    const int nw = chainwg ? CH_NSEG * NCHAIN * NPAIR : (F.G - NCHAIN) * NWAVES;
                    const float* sinks = INP(I_SINK, NH);
                    const bool attfirst = !chainwg && ((F.bid >> 3) & 1);
                    int au = chainwg ? 2048 : ATT_CH * NCHAIN + F.bid - NCHAIN;
#pragma unroll 1
                    for (int u0 = chainwg ? F.bid * NWAVES : NCHAIN * NWAVES + (F.bid - NCHAIN) * NWAVES; u0 < CH_NSEG * NCHAIN * NPAIR || au < 2048; u0 += nw) {
                        const int u = u0 + F.wave;
#pragma unroll 1
                        for (int st = 0; st < 2; ++st) {
                        if ((st == 0) != attfirst) {
                        if (u < CH_NSEG * NCHAIN * NPAIR) {
                        const int seg = u / (NCHAIN * NPAIR), r = u % (NCHAIN * NPAIR), chain = r >> 6, pl = r & (NPAIR - 1);
                        if (seg >= NFB) XB_SPIN(xb_ld(hw + CW_SDONE + ((seg - NFB) * NCHAIN + chain) * 64) == 0u, bar);
                        const __amdgpu_buffer_rsrc_t blk = __builtin_amdgcn_make_buffer_rsrc(fb + (size_t)(seg % NFB) * SEG_BYTES + (size_t)r * PRB, 0, PRB, 0x00020000);
#pragma unroll 1
                        for (int rp_ = 0; rp_ < PROBE_REPS(21); ++rp_) {
                        v4u A1P[3][2];
                        chunkA_unit<0>(F.lane, chain, seg * CH_SEGCH + 2 * pl, a3, blk, sc, pw0, pa0, pk_a, pr_k, bonus, A1P, park, park2);
                        chunkA_unit<1>(F.lane, chain, seg * CH_SEGCH + 2 * pl + 1, a3, blk, sc, pw0, pa0, pk_a, pr_k, bonus, A1P, park, park2); }
                        asm volatile("s_waitcnt vmcnt(0)" ::: "memory");
                        if (F.lane == 0) (void)xb_add(hw + (seg * NCHAIN + chain) * 64, 1u);
                        }
                        __syncthreads();
                        } else
                        if (au < 2048) {
                            Frame FA = F; { int t_ = F.tid; asm volatile("" : "+v"(t_)); FA.tid = t_; FA.lane = t_ & 63; FA.wave = __builtin_amdgcn_readfirstlane(t_ >> 6); }
                            unsigned char* a2q = a2; const float* snk = sinks; asm volatile("" : "+s"(a2q), "+s"(snk));
                            attn_unit(FA, au, a2q, snk); au += F.G - NCHAIN; __syncthreads(); }
                        }
                    }
                    if (F.tid < 32) ((volatile LAS unsigned*)(F.lds + MISC_OFF))[F.tid] = 0u;
                    __syncthreads();
                }
            }
            if (F0.bid < NCHAIN) {
                PHASE_BEGIN();
                unsigned* hw = ctl + CW_SCAN + (size_t)(layer * 2 + rep_) * (CH_NSEG * NCHAIN * 64);
                chunkB_chain(F, F.bid, ws + WS_SFRAG, a2, hw, ctl + CW_BAR);
            }
            {
                PHASE_BEGIN();
                const float* sinks = INP(I_SINK, NH);
                if (F.bid < NCHAIN) {
#pragma unroll 1
                    for (int u = F.bid; u < ATT_CH * NCHAIN; u += NCHAIN) attn_unit(F, u, a2, sinks);
                }
            }
            GRID_BAR();
        }
        if constexpr (IN(6)) for (int rep_ = 0; rep_ < PROBE_REPS(6); ++rep_) {
            PHASE_BEGIN();
            const float* ln_g = INP(I_LNG, C); const float* ln_b = INP(I_LNB, C);
            postscan_phase(F, a2, a3, ln_g, ln_b, (const float*)(ws + WS_BON));
            GRID_BAR();
        }
        if constexpr (IN(7)) for (int rep_ = 0; rep_ < PROBE_REPS(7); ++rep_) {
            PHASE_BEGIN();
            DenseSched S{(const char*)Hb, (const char*)(WinT + (size_t)NPROJ * D), (size_t)256 * D * 2, (size_t)256 * D * 2, 128, 24, F.G, F.bid};
            EpiGates E{(bf16*)a3};
            pg::gemm_phase<EpiGates, DenseSched, false>(ring, D * 2, D * 2, D, S, E);
            GRID_BAR();
        }
        if constexpr (IN(8)) for (int rep_ = 0; rep_ < PROBE_REPS(8); ++rep_) {
            PHASE_BEGIN();
            BranchSched S{(const char*)a2, (const char*)WbT, F.G, F.bid};
            EpiBranch E{(const bf16*)a3, merged};
            pg::gemm_phase<EpiBranch, BranchSched, false>(ring, C * 2, C * 2, C, S, E);
            GRID_BAR();
        }
        if constexpr (IN(9)) {
#pragma unroll 1
            for (int step = 0; step < 2; ++step) {
            if ((step == 0) != ((F0.bid & 4) != 0)) { PHASE_BEGIN();
              const float* x_in = INP(I_X, 0);
              DenseSched S{(const char*)merged, (const char*)WoT, (size_t)256 * D * 2, (size_t)256 * D * 2, 128, 8, F.G, F.bid};
              EpiResid E{layer == 0 ? x_in : out, out};
              pg::gemm_phase<EpiResid, DenseSched, false>(ring, D * 2, D * 2, D, S, E); }
            else { PHASE_BEGIN();
              const float* ew1 = INP(I_W1, (size_t)NEXP * D * FF); const float* ew3 = INP(I_W3, (size_t)NEXP * D * FF); const float* ew2 = INP(I_W2, (size_t)NEXP * FF * D);
              expert_items(ew1, ew3, ew2, W13T, W2T, EXP_P11, 2 * 16384, F.gw, F.NGW, F.lane); }
            }
            GRID_BAR();
        }
        if constexpr (IN(10)) for (int rep_ = 0; rep_ < PROBE_REPS(10); ++rep_) {
            PHASE_BEGIN();
            const float* ffn_norm = INP(I_FFN_NORM, D);
            {
#pragma unroll 1
                for (int m = F.gw; m < NT; m += 2 * F.NGW) {
                    const int m1 = m + F.NGW; const bool has1 = m1 < NT;
                    f32x4 va[8], vb[8];
                    const GAS f32x4* xa = (const GAS f32x4*)(out + (size_t)m * D) + F.lane; const GAS f32x4* xb = (const GAS f32x4*)(out + (size_t)(has1 ? m1 : m) * D) + F.lane;
#pragma unroll
                    for (int j = 0; j < 8; ++j) { va[j] = xa[64 * j]; vb[j] = xb[64 * j]; }
                    rms_store(va, ffn_norm, Hb + (size_t)m * D, F.lane);
                    if (has1) rms_store(vb, ffn_norm, Hb + (size_t)m1 * D, F.lane);
                }
            }
            GRID_BAR();
        }
        if constexpr (IN(11)) for (int rep_ = 0; rep_ < PROBE_REPS(11); ++rep_) {
            PHASE_BEGIN();
            DenseSched S{(const char*)Hb, (const char*)WrT, (size_t)256 * D * 2, (size_t)256 * D * 2, 128, 1, F.G, F.bid};
            EpiRouter E{logits};
            pg::gemm_phase<EpiRouter, DenseSched, false>(ring, D * 2, D * 2, D, S, E);
            if (F.G > 128 && F.bid >= 128) {
                const float* ew1 = INP(I_W1, (size_t)NEXP * D * FF); const float* ew3 = INP(I_W3, (size_t)NEXP * D * FF); const float* ew2 = INP(I_W2, (size_t)NEXP * FF * D);
                expert_items(ew1, ew3, ew2, W13T, W2T, 0, EXP_P11, (F.bid - 128) * NWAVES + F.wave, (F.G - 128) * NWAVES, F.lane); }
            else if (F.G <= 128) { const float* ew1 = INP(I_W1, (size_t)NEXP * D * FF); const float* ew3 = INP(I_W3, (size_t)NEXP * D * FF); const float* ew2 = INP(I_W2, (size_t)NEXP * FF * D);
                expert_items(ew1, ew3, ew2, W13T, W2T, 0, EXP_P11, F.gw, F.NGW, F.lane); }
            GRID_BAR();
        }
        if constexpr (IN(12)) {
            PHASE_BEGIN();
            const float* rgb = INP(I_RGB, 4); const float* reb = INP(I_REB, 32);
            route_tokens(F, layer, logits, rgb, reb, ctl + CW_CNT, list, tg);
            GRID_BAR();
        }
        if constexpr (IN(13)) for (int rep_ = 0; rep_ < PROBE_REPS(13); ++rep_) {
            PHASE_BEGIN();
            LAS int* rb2e = (LAS int*)(F.lds + TBL_OFF); LAS int* rows = rb2e + 512;
            const int RB = moe_tables(F, layer, ctl + CW_CNT, list, 4, false, rb2e, rows);
            typedef MoeSched<4, (size_t)1024 * D * 2, (size_t)256 * D * 2, 0> SchedUp; SchedUp S{(const char*)Hb, (const char*)W13T, RB * 4, F.G, F.bid, rb2e, rows};
            EpiMoeUp E{HM};
            pg::gemm_phase<EpiMoeUp, SchedUp, true>(ring, D * 2, D * 2, D, S, E);
            { const int extra = (RB * 4) % F.G;
              if (F.bid >= extra) { const float* ew1 = INP(I_W1, (size_t)NEXP * D * FF); const float* ew3 = INP(I_W3, (size_t)NEXP * D * FF); const float* ew2 = INP(I_W2, (size_t)NEXP * FF * D);
                expert_items(ew1, ew3, ew2, W13T, W2T, 2 * 16384, 3 * 16384, (F.bid - extra) * NWAVES + F.wave, (F.G - extra) * NWAVES, F.lane); } }
            GRID_BAR();
        }
        if constexpr (IN(14)) for (int rep_ = 0; rep_ < PROBE_REPS(14); ++rep_) {
            PHASE_BEGIN();
            LAS int* rb2e = (LAS int*)(F.lds + TBL_OFF); LAS int* rows = rb2e + 512;
            const int RB = moe_tables(F, layer, ctl + CW_CNT, list, 8, true, rb2e, rows);
            typedef MoeSched<8, (size_t)D * FF * 2, (size_t)256 * FF * 2, (size_t)256 * FF * 2> SchedDn; SchedDn S{(const char*)HM, (const char*)W2T, RB * 8, F.G, F.bid, rb2e, rows};
            EpiMoeDown E{Y2, rows};
            pg::gemm_phase<EpiMoeDown, SchedDn, false>(ring, FF * 2, FF * 2, FF, S, E);
            GRID_BAR();
        }
        if constexpr (IN(15)) if (layer == DEPTH - 1) {
            PHASE_BEGIN();
            {
#pragma unroll 1
                for (int m = F.gw; m < NT; m += F.NGW) {
                    f32x4 v[8]; GAS f32x4* xr = (GAS f32x4*)(out + (size_t)m * D) + F.lane;
#pragma unroll
                    for (int j = 0; j < 8; ++j) v[j] = xr[64 * j];
                    moe_combine(v, Y2, tg, m, F.lane);
#pragma unroll
                    for (int j = 0; j < 8; ++j) xr[64 * j] = v[j];
                }
            }
        }
    }
#undef IN
}

template <int P> static void launch_phase(int grid, hipStream_t stream, Args a) { hipLaunchKernelGGL((mega_fwd<P, P + 1>), dim3(grid), dim3(NWAVES * 64), LDS_BYTES, stream, a); }
template <int P> static bool set_attr() { return hipFuncSetAttribute((const void*)mega_fwd<P, P + 1>, hipFuncAttributeMaxDynamicSharedMemorySize, LDS_BYTES) == hipSuccess; }
extern "C" void kernel_launch(void* const* d_in, const int* in_sizes, int n_in, void* d_out, int out_size, void* d_ws, size_t ws_size, hipStream_t stream) {
    static int grid = 0;
    if (grid == 0) {
        if (n_in != 30 || out_size != NT * D || ws_size < WS_END) { fprintf(stderr, "kernel_launch: unexpected problem (n_in %d, out %d, ws %zu < %zu)\n", n_in, out_size, ws_size, (size_t)WS_END); grid = -1; return; }
        int dev = 0, cus = 0;
        if (hipGetDevice(&dev) != hipSuccess || hipDeviceGetAttribute(&cus, hipDeviceAttributeMultiprocessorCount, dev) != hipSuccess) { grid = -1; return; }
#if MK_ONE_LAUNCH
        bool ok = hipFuncSetAttribute((const void*)mega_fwd<0, NPH + 1>, hipFuncAttributeMaxDynamicSharedMemorySize, LDS_BYTES) == hipSuccess;
#else
        bool ok = set_attr<0>() && set_attr<1>() && set_attr<2>() && set_attr<3>() && set_attr<4>() && set_attr<5>() && set_attr<6>() && set_attr<7>() && set_attr<8>() && set_attr<9>() && set_attr<10>() && set_attr<11>() && set_attr<12>() && set_attr<13>() && set_attr<14>() && set_attr<15>();
#endif
        if (!ok) { fprintf(stderr, "kernel_launch: hipFuncSetAttribute failed\n"); grid = -1; return; }
        (void)hipGetLastError();
        grid = cus;
    }
    if (grid < 0) return;
    if (hipMemsetAsync((char*)d_ws + WS_CTL, 0, CTL_BYTES, stream) != hipSuccess) return;
    Args a{};
    for (int i = 0; i < 30; ++i) a.in[i] = d_in[i];
    a.out = (float*)d_out; a.ws = (unsigned char*)d_ws;
#if MK_ONE_LAUNCH
    a.l_lo = 0; a.l_hi = DEPTH; a.ph_lo = 0; a.ph_hi = NPH + 1;
    hipLaunchKernelGGL((mega_fwd<0, NPH + 1>), dim3(grid), dim3(NWAVES * 64), LDS_BYTES, stream, a);
#else
    for (int l = 0; l < DEPTH; ++l) {
        a.l_lo = l; a.l_hi = l + 1; a.ph_lo = 0; a.ph_hi = 0;
        launch_phase<0>(grid, stream, a); launch_phase<1>(grid, stream, a); launch_phase<2>(grid, stream, a); launch_phase<3>(grid, stream, a); launch_phase<4>(grid, stream, a);
        launch_phase<5>(grid, stream, a); launch_phase<6>(grid, stream, a); launch_phase<7>(grid, stream, a); launch_phase<8>(grid, stream, a); launch_phase<9>(grid, stream, a);
        launch_phase<10>(grid, stream, a); launch_phase<11>(grid, stream, a); launch_phase<12>(grid, stream, a); launch_phase<13>(grid, stream, a); launch_phase<14>(grid, stream, a);
        if (l == DEPTH - 1) launch_phase<15>(grid, stream, a);
    }
#endif
}
```

```cpp
#include <hip/hip_runtime.h>
#include <cstdio>
#include <cstdint>

#ifndef PROBE_MASK
#define PROBE_MASK 0
#endif
#define PROBE_REPS(k) (((PROBE_MASK >> (k)) & 1) ? 2 : 1)
#ifndef MK_ONE_LAUNCH
#define MK_ONE_LAUNCH 1
#endif

#define GAS __attribute__((address_space(1)))
#define LAS __attribute__((address_space(3)))
typedef unsigned short bf16;
typedef _Float16 f16;
typedef unsigned v4u __attribute__((ext_vector_type(4)));
typedef unsigned v2u __attribute__((ext_vector_type(2)));
typedef float f32x2 __attribute__((ext_vector_type(2)));
typedef float f32x4 __attribute__((ext_vector_type(4)));
typedef float f32x16 __attribute__((ext_vector_type(16)));
typedef short bf16x8 __attribute__((ext_vector_type(8)));
typedef short s16x4 __attribute__((ext_vector_type(4)));
typedef _Float16 f16x4 __attribute__((ext_vector_type(4)));
typedef _Float16 f16x8 __attribute__((ext_vector_type(8)));
typedef GAS unsigned gu32;
#define DI __device__ __forceinline__
#define RLX_AGENT __ATOMIC_RELAXED, __HIP_MEMORY_SCOPE_AGENT
#define LDS_WAIT() asm volatile("s_waitcnt lgkmcnt(0)" ::: "memory")
#define VM_WAIT() asm volatile("s_waitcnt vmcnt(0)" ::: "memory")

constexpr int NB = 2, SEQ = 16384, NT = NB * SEQ, D = 2048, C = 1024, NH = 16, HD = 64, DEPTH = 2;
constexpr int ZC = 3520, ZP = 3584;
constexpr int NPROJ = 6144;
constexpr int NGATE = 6144, INC = 12224, INP = 12288;
constexpr int NEXP = 32, FF = 512;
constexpr int NCHAIN = NB * NH;
constexpr int HM_ROWS = 73728;
constexpr float NORM_EPS = 1e-6f, GN_EPS = 64e-5f;

constexpr size_t MiB = 1u << 20;
constexpr size_t WS_CTL = 0, CTL_BYTES = 1 * MiB;
constexpr size_t WS_W = 1 * MiB;
constexpr size_t W_WIN = 0, W_LORA = 48 * MiB, W_POOL = W_LORA + 3 * 1024 * 256 * 2, W_BR = 50 * MiB, W_WO = 62 * MiB, W_RT = 70 * MiB;
constexpr size_t WS_H = 72 * MiB;
constexpr size_t WS_A2 = 200 * MiB;
constexpr size_t A2_Z = 0, A2_U = 224 * MiB, A2_Q = 288 * MiB, A2_K = 352 * MiB, A2_V = 368 * MiB;
constexpr size_t A2_G = 0, A2_BOUT = 64 * MiB, A2_COUT = 128 * MiB, A2_Y = 224 * MiB, A2_AOUT = 288 * MiB;
constexpr size_t A2_HM = 0, A2_Y2 = 72 * MiB;
constexpr size_t WS_A3 = 584 * MiB;
constexpr size_t PLANE = 64 * MiB;
enum { PL_R = 0, PL_W = 1, PL_K = 2, PL_V = 3, PL_KK = 4, PL_B = 5 };
constexpr size_t A3_W13 = 0, A3_W2 = 128 * MiB;
constexpr size_t WS_A4 = 968 * MiB;
constexpr size_t A4_LORA = 0, A4_POOL = 64 * MiB;
constexpr size_t WS_LOG = 1096 * MiB;
constexpr size_t WS_LIST = 1104 * MiB;
constexpr size_t WS_TG = 1108 * MiB;
constexpr size_t WS_FRAG = 1109 * MiB;
constexpr size_t FRAG_BUF = 80 * MiB, FRAG_V = 64 * MiB;
constexpr size_t WS_SFRAG = 968 * MiB;
constexpr size_t WS_BON = 1269 * MiB;
constexpr size_t WS_END = 1271 * MiB;
constexpr int CW_BAR = 4096;
constexpr int CW_SCAN = 32768, CW_SDONE = 4 * 8 * 32 * 64;
constexpr int CW_CNT = 16384;

constexpr int RING_BYTES = 131072;
constexpr int TBL_OFF = RING_BYTES;
constexpr int MISC_OFF = RING_BYTES + 16384;
constexpr int XTR_OFF = 151552;
constexpr int LDS_BYTES = 163840;
constexpr int NWAVES = 8;

DI unsigned f2bf(float f) { unsigned u = __builtin_bit_cast(unsigned, f); return (u + 0x7fffu + ((u >> 16) & 1u)) >> 16; }
DI float bflo(unsigned u) { return __builtin_bit_cast(float, u << 16); }
DI float bfhi(unsigned u) { return __builtin_bit_cast(float, u & 0xffff0000u); }
DI unsigned cvt_pk_bf16(float lo, float hi) { unsigned r; asm volatile("v_cvt_pk_bf16_f32 %0, %1, %2" : "=v"(r) : "v"(lo), "v"(hi)); return r; }
typedef __bf16 bf16x2_t __attribute__((ext_vector_type(2)));
DI unsigned cvt_pk_bf16_c(float lo, float hi) { const f32x2 v = {lo, hi}; return __builtin_bit_cast(unsigned, __builtin_convertvector(v, bf16x2_t)); }
DI unsigned pk2(float lo, float hi) { return cvt_pk_bf16_c(lo, hi); }
DI unsigned pkh2(float lo, float hi) { typedef _Float16 h2 __attribute__((ext_vector_type(2))); h2 v; v.x = (f16)lo; v.y = (f16)hi; return __builtin_bit_cast(unsigned, v); }
DI float hlo(unsigned u) { typedef _Float16 h2 __attribute__((ext_vector_type(2))); h2 v = __builtin_bit_cast(h2, u); return (float)v.x; }
DI float hhi(unsigned u) { typedef _Float16 h2 __attribute__((ext_vector_type(2))); h2 v = __builtin_bit_cast(h2, u); return (float)v.y; }
DI void unpack_bf8(v4u p, float (&o)[8]) { o[0] = bflo(p.x); o[1] = bfhi(p.x); o[2] = bflo(p.y); o[3] = bfhi(p.y); o[4] = bflo(p.z); o[5] = bfhi(p.z); o[6] = bflo(p.w); o[7] = bfhi(p.w); }
DI void unpack_h8(v4u p, float (&o)[8]) { o[0] = hlo(p.x); o[1] = hhi(p.x); o[2] = hlo(p.y); o[3] = hhi(p.y); o[4] = hlo(p.z); o[5] = hhi(p.z); o[6] = hlo(p.w); o[7] = hhi(p.w); }
DI v4u pack_bf8(const float (&o)[8]) { v4u w; w.x = pk2(o[0], o[1]); w.y = pk2(o[2], o[3]); w.z = pk2(o[4], o[5]); w.w = pk2(o[6], o[7]); return w; }
DI v4u pack_h8(const float (&o)[8]) { v4u w; w.x = pkh2(o[0], o[1]); w.y = pkh2(o[2], o[3]); w.z = pkh2(o[4], o[5]); w.w = pkh2(o[6], o[7]); return w; }
DI float sigmoidf_(float x) { return 1.0f / (1.0f + __expf(-x)); }
DI float rcpf_(float x) { return __builtin_amdgcn_rcpf(x); }
DI float sigmoid_r(float x) { return rcpf_(1.0f + __expf(-x)); }
template <int CTRL> DI float dpp_mov(float v) { return __builtin_bit_cast(float, __builtin_amdgcn_update_dpp(0, __builtin_bit_cast(int, v), CTRL, 0xf, 0xf, false)); }
DI float grp8_sum(float v) { v += dpp_mov<0xB1>(v); v += dpp_mov<0x4E>(v); v += dpp_mov<0x141>(v); return v; }
DI float grp32_sum(float v) { v = grp8_sum(v); v += dpp_mov<0x140>(v); v += __builtin_bit_cast(float, __builtin_amdgcn_ds_swizzle(__builtin_bit_cast(int, v), 0x401F)); return v; }
DI float wave_sum(float v) { v = grp32_sum(v); v += __shfl_xor(v, 32); return v; }

namespace pg {
constexpr int BM = 256, BK = 64, HALF = 128, HTB = HALF * BK * 2, STAGE_BYTES = 8 * HTB, NXCD = 8, WGM = 4;
DI int lds_byte(int r, int c) { const int st = (r >> 4) * 2 + (c >> 5), rr = r & 15, cc = c & 31, ob = rr * 64 + cc * 2; return st * 1024 + (ob ^ (((ob >> 9) & 1) << 5)); }
DI void stage_rc(int b, int& R, int& Cc) { const int st = b / 1024, sb = b % 1024, swz = sb ^ (((sb >> 9) & 1) << 5); R = (st >> 1) * 16 + swz / 64; Cc = (st & 1) * 32 + (swz % 64) / 2; }
DI int perm32(int rho) { const int n = rho >> 4, i = rho & 15; return 8 * (i >> 2) + 4 * n + (i & 3); }

struct Unit { const char* A; const char* B; int pm, pn, aux; };
DI const char* launder(const char* p) { asm volatile("" : "+s"(p)); return p; }

DI bool static_tile(long L, int nM, int nN, int& pm, int& pn) {
    const int nwg = nM * nN; if (L >= nwg) return false;
    int wgid = (int)L; { const int q = nwg / NXCD, r = nwg % NXCD, xcd = wgid % NXCD, off = wgid / NXCD; wgid = (xcd < r ? xcd * (q + 1) : r * (q + 1) + (xcd - r) * q) + off; }
    const int nig = WGM * nN, gid = wgid / nig, fm = gid * WGM, gsz = (nM - fm) < WGM ? (nM - fm) : WGM;
    pm = fm + ((wgid % nig) % gsz); pn = (wgid % nig) / gsz; return true;
}

template <class Epi, class Sched, bool GATHER>
DI void gemm_phase(LAS unsigned char* lds, const int lda, const int ldb, const int K, const Sched& S, const Epi& E) {
    int tid_ = threadIdx.x; asm volatile("" : "+v"(tid_));
    const int tid = tid_, wid = __builtin_amdgcn_readfirstlane(tid >> 6), lane = tid & 63, wr = wid >> 2, wc = wid & 3, fr = lane & 15, fq = lane >> 4;
    const int nt = K / BK;
    unsigned voffA[2][2], voffB[2]; int rowA[2], colA[2];
#pragma unroll
    for (int i = 0; i < 2; ++i) { int R, Cc; stage_rc(tid * 16 + i * 8192, R, Cc); const int Rb = Epi::PERM ? ((R & ~31) + perm32(R & 31)) : R;
        rowA[i] = R; colA[i] = Cc * 2;
        voffA[0][i] = (unsigned)(R * lda + Cc * 2); voffA[1][i] = voffA[0][i] + (unsigned)(HALF * lda); voffB[i] = (unsigned)(Rb * ldb + Cc * 2); }
    const size_t kstep = (size_t)(BK * 2);
    const size_t hstepB = (size_t)HALF * ldb;
    const unsigned ldsw = (unsigned)wid * 1024u;
    const int aoff = lds_byte(wr * 64 + fr, fq * 8), boff = lds_byte(wc * 32 + fr, fq * 8);
#define PG_SA(b, h) (((b) * 2 + (h)) * HTB)
#define PG_SB(b, h) ((4 + (b) * 2 + (h)) * HTB)
#define PG_STAGE_A(bufoff, h, gbase) do { _Pragma("unroll") for (int _i = 0; _i < 2; ++_i) \
        __builtin_amdgcn_global_load_lds((const unsigned*)((const char*)(gbase) + voffA[h][_i]), (LAS unsigned*)(lds + (bufoff) + ldsw + _i * 8192), 16, 0, 0); } while (0)
#define PG_STAGE_B(bufoff, gbase) do { _Pragma("unroll") for (int _i = 0; _i < 2; ++_i) \
        __builtin_amdgcn_global_load_lds((const unsigned*)((const char*)(gbase) + voffB[_i]), (LAS unsigned*)(lds + (bufoff) + ldsw + _i * 8192), 16, 0, 0); } while (0)
#define PG_LDA(dst, b, h) do { _Pragma("unroll") for (int m = 0; m < 4; ++m) _Pragma("unroll") for (int k = 0; k < 2; ++k) dst[m][k] = *(const LAS bf16x8*)(lds + PG_SA(b, h) + aoff + m * 2048 + k * 1024); } while (0)
#define PG_LDB(dst, b, h) do { _Pragma("unroll") for (int n = 0; n < 2; ++n) _Pragma("unroll") for (int k = 0; k < 2; ++k) dst[n][k] = *(const LAS bf16x8*)(lds + PG_SB(b, h) + boff + n * 2048 + k * 1024); } while (0)
#define PG_MMA(ai, bj, At, Bt) do { __builtin_amdgcn_s_setprio(1); _Pragma("unroll") for (int m = 0; m < 4; ++m) _Pragma("unroll") for (int n = 0; n < 2; ++n) _Pragma("unroll") for (int k = 0; k < 2; ++k) \
        acc[ai][bj][m][n] = __builtin_amdgcn_mfma_f32_16x16x32_bf16(Bt[n][k], At[m][k], acc[ai][bj][m][n], 0, 0, 0); __builtin_amdgcn_s_setprio(0); } while (0)
#define PG_WAIT_V(n) asm volatile("s_waitcnt vmcnt(" #n ")" ::: "memory")
#define PG_WAIT_L(n) asm volatile("s_waitcnt lgkmcnt(" #n ")" ::: "memory")
#define PG_BAR __builtin_amdgcn_s_barrier()
#define PG_SCHED __builtin_amdgcn_sched_barrier(0)
#define PG_GATHER(u) do { if constexpr (GATHER) { _Pragma("unroll") for (int _h = 0; _h < 2; ++_h) _Pragma("unroll") for (int _i = 0; _i < 2; ++_i) voffA[_h][_i] = S.row_off(u, _h * HALF + rowA[_i]) + (unsigned)colA[_i]; } } while (0)
    Unit cur, nxt; int ui = 0;
    if (!S.next(0, cur)) return;
    f32x4 acc[2][2][4][2];
#pragma unroll
    for (int a = 0; a < 2; ++a)
#pragma unroll
        for (int b = 0; b < 2; ++b)
#pragma unroll
            for (int m = 0; m < 4; ++m)
#pragma unroll
                for (int n = 0; n < 2; ++n) acc[a][b][m][n] = (f32x4){0.f, 0.f, 0.f, 0.f};
    bf16x8 At[4][2], B0[2][2], B1[2][2];
    const char* cA = launder(cur.A); const char* cB = launder(cur.B);
    PG_GATHER(cur);
    PG_STAGE_B(PG_SB(0, 0), cB); PG_STAGE_B(PG_SB(0, 1), cB + hstepB); PG_STAGE_A(PG_SA(0, 0), 0, cA); PG_STAGE_A(PG_SA(0, 1), 1, cA);
    if (wr == 1) PG_BAR;
    PG_WAIT_V(2); PG_BAR;
    PG_STAGE_B(PG_SB(1, 0), cB + kstep); PG_STAGE_A(PG_SA(1, 0), 0, cA + kstep); PG_STAGE_B(PG_SB(1, 1), cB + hstepB + kstep);
    PG_WAIT_V(6); PG_BAR;
    for (;;) {
        const bool has_next = S.next(ui + 1, nxt);
        const char* nA = launder(has_next ? nxt.A : cA); const char* nB = launder(has_next ? nxt.B : cB);
#pragma unroll 1
        for (int t = 0; t < nt; t += 2) {
            const bool last = (t == nt - 2);
            const char* a1 = cA + (size_t)(t + 1) * kstep;
            const char* a2 = last ? nA : cA + (size_t)(t + 2) * kstep; const char* b2 = last ? nB : cB + (size_t)(t + 2) * kstep;
            const char* a3 = a2 + kstep; const char* b3 = b2 + kstep;
            PG_LDB(B0, 0, 0); PG_LDB(B1, 0, 1); PG_SCHED; PG_LDA(At, 0, 0); PG_STAGE_A(PG_SA(1, 1), 1, a1);
            PG_WAIT_V(8); PG_WAIT_L(0); PG_BAR; PG_MMA(0, 0, At, B0); PG_MMA(0, 1, At, B1); PG_BAR; PG_SCHED;
            if (last && has_next) PG_GATHER(nxt);
            PG_LDA(At, 0, 1); PG_STAGE_B(PG_SB(0, 0), b2); PG_STAGE_B(PG_SB(0, 1), b2 + hstepB); PG_STAGE_A(PG_SA(0, 0), 0, a2);
            PG_WAIT_V(8); PG_WAIT_L(0); PG_BAR; PG_MMA(1, 0, At, B0); PG_MMA(1, 1, At, B1); PG_BAR; PG_SCHED;
            PG_LDB(B0, 1, 0); PG_LDB(B1, 1, 1); PG_SCHED; PG_LDA(At, 1, 0); PG_STAGE_A(PG_SA(0, 1), 1, a2);
            PG_WAIT_V(8); PG_WAIT_L(0); PG_BAR; PG_MMA(0, 0, At, B0); PG_MMA(0, 1, At, B1); PG_BAR; PG_SCHED;
            PG_LDA(At, 1, 1); PG_STAGE_B(PG_SB(1, 0), b3); PG_STAGE_B(PG_SB(1, 1), b3 + hstepB); PG_STAGE_A(PG_SA(1, 0), 0, a3);
            PG_WAIT_V(8); PG_WAIT_L(0); PG_BAR; PG_MMA(1, 0, At, B0); PG_MMA(1, 1, At, B1); PG_BAR; PG_SCHED;
        }
        if (wr == 0) PG_BAR;
        E(acc, cur, wr, wc, fr, fq);
        if (!has_next) break;
#pragma unroll
        for (int a = 0; a < 2; ++a)
#pragma unroll
            for (int b = 0; b < 2; ++b)
#pragma unroll
                for (int m = 0; m < 4; ++m)
#pragma unroll
                    for (int n = 0; n < 2; ++n) acc[a][b][m][n] = (f32x4){0.f, 0.f, 0.f, 0.f};
        cur = nxt; cA = nA; cB = nB; ++ui;
        if (wr == 1) PG_BAR;
    }
    PG_WAIT_V(0);
    PG_BAR;
#undef PG_SA
#undef PG_SB
#undef PG_STAGE_A
#undef PG_STAGE_B
#undef PG_LDA
#undef PG_LDB
#undef PG_MMA
#undef PG_WAIT_V
#undef PG_WAIT_L
#undef PG_BAR
#undef PG_SCHED
#undef PG_GATHER
}
}

#define XB_TMO      128
#define XB_XCNT(j)  (256  + 64 * (j))
#define XB_XSUB(j)  (1280 + 64 * (j))
#define XB_XGEN(j)  (2304 + 64 * (j))
#define XB_TOP      3328
#define XB_TOPGEN   3392
#define XCD_BAR_WORDS 3456
#define XB_SPIN_CAP (1u << 22)
DI unsigned xb_ld(unsigned* p)              { return __hip_atomic_load(p, __ATOMIC_RELAXED, __HIP_MEMORY_SCOPE_AGENT); }
DI unsigned xb_add(unsigned* p, unsigned v) { return __hip_atomic_fetch_add(p, v, __ATOMIC_RELAXED, __HIP_MEMORY_SCOPE_AGENT); }
DI unsigned xb_xcc_id() { return (unsigned)__builtin_amdgcn_s_getreg((3 << 11) | 20) & 0xFu; }
#define XB_SPIN(cond, bar) do { unsigned _sp = 0; while (cond) { __builtin_amdgcn_s_sleep(1); \
    if ((++_sp & 255u) == 0u) { if (xb_ld(&(bar)[XB_TMO])) break; if (_sp > XB_SPIN_CAP) { atomicAdd(&(bar)[XB_TMO], 1u); break; } } } } while (0)
struct XcdBarrier { unsigned* bar; unsigned x; volatile LAS unsigned* st; };
DI XcdBarrier xcd_barrier_post(unsigned* bar, volatile LAS unsigned* st) {
    XcdBarrier b; b.bar = bar; b.x = xb_xcc_id(); b.st = st;
    if (threadIdx.x == 0) (void)xb_add(&bar[XB_XCNT(b.x)], 1u);
    return b;
}
DI void xcd_barrier_complete(unsigned* bar, unsigned x, unsigned& nloc, unsigned& nx) {
    const unsigned G = gridDim.x * gridDim.y * gridDim.z;
    unsigned sum, cnt, mine, sp = 0u;
    for (;;) {
        sum = 0u; cnt = 0u; mine = 0u;
#pragma unroll
        for (unsigned j = 0; j < 16; ++j) { const unsigned c = xb_ld(&bar[XB_XCNT(j)]); sum += c; cnt += (c > 0u) ? 1u : 0u; mine = (j == x) ? c : mine; }
        if (sum == G) break;
        __builtin_amdgcn_s_sleep(1);
        if ((++sp & 255u) == 0u) { if (xb_ld(&bar[XB_TMO])) break; if (sp > XB_SPIN_CAP) { atomicAdd(&bar[XB_TMO], 1u); break; } }
    }
    nloc = mine > 0u ? mine : 1u; nx = cnt > 0u ? cnt : 1u;
}
DI void xcd_barrier(const XcdBarrier& b) {
    asm volatile("s_waitcnt vmcnt(0)" ::: "memory");
    __syncthreads();
    if (threadIdx.x == 0) {
        unsigned* bar = b.bar; asm volatile("" : "+s"(bar));
        __builtin_amdgcn_s_waitcnt(0);
        unsigned nloc = b.st[0], nx = b.st[1];
        if (nloc == 0u) { xcd_barrier_complete(bar, b.x, nloc, nx); b.st[0] = nloc; b.st[1] = nx; }
        const unsigned old = xb_add(&bar[XB_XSUB(b.x)], 1u);
        const unsigned gen = old / nloc;
        if (old + 1u == (gen + 1u) * nloc) {
            __builtin_amdgcn_fence(__ATOMIC_RELEASE, "agent");
            asm volatile("s_waitcnt vmcnt(0)" ::: "memory");
            const unsigned og = xb_add(&bar[XB_TOP], 1u);
            const unsigned tg = og / nx;
            if (og + 1u == (tg + 1u) * nx) xb_add(&bar[XB_TOPGEN], 1u);
            else XB_SPIN(xb_ld(&bar[XB_TOPGEN]) == tg, bar);
            __builtin_amdgcn_fence(__ATOMIC_ACQUIRE, "agent");
            xb_add(&bar[XB_XGEN(b.x)], 1u);
            asm volatile("s_waitcnt vmcnt(0)" ::: "memory");
        } else {
            XB_SPIN(xb_ld(&bar[XB_XGEN(b.x)]) == gen, bar);
            __builtin_amdgcn_fence(__ATOMIC_ACQUIRE, "agent");
            asm volatile("s_waitcnt vmcnt(0)" ::: "memory");
        }
    }
    __syncthreads();
}

struct Args { const void* in[30]; float* out; unsigned char* ws; int l_lo, l_hi, ph_lo, ph_hi; };
enum { I_X = 0, I_POS, I_ATTN_NORM, I_WIN, I_MU, I_W0, I_WUP, I_A0, I_AUP, I_GUP, I_KK, I_KA, I_RK, I_LNG, I_LNB, I_POOLW, I_POOLS, I_QN, I_KN, I_SINK,
       I_WBR, I_WOUT, I_FFN_NORM, I_RGW, I_RGB, I_REW, I_REB, I_W1, I_W3, I_W2 };
constexpr int NPH = 15;

struct Frame {
    LAS unsigned char* lds;
    unsigned char* ws;
    int tid, lane, wave, G, bid, gw, NGW;
};

DI void tr_load(f32x4 (&v)[8], const float* W, int N, int k0, int n0, int lane) {
    const GAS float* p = (const GAS float*)W + (size_t)(k0 + 8 * (lane >> 3)) * N + n0 + 4 * (lane & 7);
#pragma unroll
    for (int i = 0; i < 8; ++i) v[i] = *(const GAS f32x4*)(p + (size_t)i * N);
}
DI void tr_store(const f32x4 (&v)[8], bf16* WT, int K, int dst_row0, int k0, int lane) {
    GAS bf16* q = (GAS bf16*)WT + (size_t)(dst_row0 + 4 * (lane & 7)) * K + k0 + 8 * (lane >> 3);
#pragma unroll
    for (int j = 0; j < 4; ++j) { v4u o; o.x = pk2(v[0][j], v[1][j]); o.y = pk2(v[2][j], v[3][j]); o.z = pk2(v[4][j], v[5][j]); o.w = pk2(v[6][j], v[7][j]);
        *(GAS v4u*)(q + (size_t)j * K) = o; }
}

DI void expert_item(int it, const float* ew1, const float* ew3, const float* ew2, bf16* W13T, bf16* W2T, const float*& W, int& K, int& N, bf16*& WT, int& drow, int& k0, int& n0) {
    const int which = it / 16384, r = it % 16384, e = r / 512, q = r % 512;
    if (which < 2) { const int kb = q / 16, nb = q % 16; n0 = 32 * nb;
        W = (which ? ew3 : ew1) + (size_t)e * D * FF; K = D; N = FF; WT = W13T + (size_t)e * 1024 * D; drow = 256 * (n0 >> 7) + (n0 & 127) + which * 128; k0 = 64 * kb; }
    else { const int kb = q / 64, nb = q % 64; W = ew2 + (size_t)e * FF * D; K = FF; N = D; WT = W2T + (size_t)e * D * FF; drow = 32 * nb; k0 = 64 * kb; n0 = 32 * nb; }
}
DI void expert_items(const float* ew1, const float* ew3, const float* ew2, bf16* W13T, bf16* W2T, int lo, int hi, int w, int nw, int lane) {
#pragma unroll 1
    for (int it = lo + w; it < hi; it += 2 * nw) {
        const int it1 = it + nw; const bool has1 = it1 < hi;
        const float* Wa; const float* Wb2; bf16* Ta; bf16* Tb; int Ka, Na, da, ka, na, Kb, Nb, db, kb2, nb2;
        expert_item(it, ew1, ew3, ew2, W13T, W2T, Wa, Ka, Na, Ta, da, ka, na); expert_item(has1 ? it1 : it, ew1, ew3, ew2, W13T, W2T, Wb2, Kb, Nb, Tb, db, kb2, nb2);
        f32x4 va[8], vb[8];
        tr_load(va, Wa, Na, ka, na, lane); tr_load(vb, Wb2, Nb, kb2, nb2, lane);
        tr_store(va, Ta, Ka, da, ka, lane);
        if (has1) tr_store(vb, Tb, Kb, db, kb2, lane);
    }
}
constexpr int EXP_P11 = 0;

struct DenseSched {
    const char* A; const char* B; size_t tstepA, tstepB; int nM, nN, G, c;
    DI bool next(int i, pg::Unit& u) const { int pm, pn; if (!pg::static_tile((long)i * G + c, nM, nN, pm, pn)) return false; u.pm = pm; u.pn = pn; u.aux = 0; u.A = A + (size_t)pm * tstepA; u.B = B + (size_t)pn * tstepB; return true; }
    DI unsigned row_off(const pg::Unit&, int) const { return 0u; }
};
struct LoraSched {
    const char* Alora; const char* Wl; int G, c;
    DI bool next(int i, pg::Unit& u) const {
        int pm, pn; if (!pg::static_tile((long)i * G + c, 128, 12, pm, pn)) return false; u.pm = pm; u.pn = pn;
        const int ty = pn >> 2, sub = pn & 3; u.aux = ty;
        u.A = Alora + (size_t)pm * 256 * 2048 + ty * 512; u.B = Wl + (size_t)ty * 1024 * 512 + (size_t)sub * 256 * 512; return true; }
    DI unsigned row_off(const pg::Unit&, int) const { return 0u; }
};
struct PoolSched {
    const char* Apool; const char* Wp; int G, c;
    DI bool next(int i, pg::Unit& u) const {
        int pm, pn; if (!pg::static_tile((long)i * G + c, 128, 4, pm, pn)) return false; u.pm = pm; u.pn = pn; u.aux = 3;
        u.A = Apool + (size_t)pm * 256 * 2048 + pn * 512; u.B = Wp + (size_t)pn * 256 * 512; return true; }
    DI unsigned row_off(const pg::Unit&, int) const { return 0u; }
};
struct BranchSched {
    const char* a2; const char* Wb; int G, c;
    DI bool next(int i, pg::Unit& u) const {
        int pm, pn; const int br = i % 3; if (!pg::static_tile((long)(i / 3) * G + c, 128, 8, pm, pn)) return false; u.pm = pm; u.pn = pn; u.aux = br;
        const size_t ao = br == 0 ? A2_AOUT : (br == 1 ? A2_BOUT : A2_COUT);
        u.A = a2 + ao + (size_t)pm * 256 * 2048; u.B = Wb + (size_t)br * 2048 * 2048 + (size_t)pn * 256 * 2048; return true; }
    DI unsigned row_off(const pg::Unit&, int) const { return 0u; }
};
template <int NCOL, size_t BSE, size_t BSN, size_t ASTR> struct MoeSched {
    const char* A; const char* B; int total, G, c; const LAS int* rb2e; const LAS int* rows;
    DI bool next(int i, pg::Unit& u) const {
        const int L = i * G + c; if (L >= total) return false;
        const int rb = L / NCOL, pn = L % NCOL; const int e = __builtin_amdgcn_readfirstlane(rb2e[rb]);
        u.pm = rb; u.pn = pn; u.aux = i; u.A = A + (size_t)rb * ASTR; u.B = B + (size_t)e * BSE + (size_t)pn * BSN; return true; }
    DI unsigned row_off(const pg::Unit& u, int r) const { return (unsigned)rows[u.aux * 256 + r] * 4096u; }
};

struct EpiProj {
    static constexpr bool PERM = true;
    unsigned char* a2;
    DI void operator()(const f32x4 (&acc)[2][2][4][2], const pg::Unit& u, int wr, int wc, int fr, int fq) const {
        bf16* base; int ld, colt;
        if (u.pn < 14) { base = (bf16*)(a2 + A2_Z); ld = ZP; colt = u.pn * 256; }
        else if (u.pn < 18) { base = (bf16*)(a2 + A2_U); ld = C; colt = (u.pn - 14) * 256; }
        else if (u.pn < 22) { base = (bf16*)(a2 + A2_Q); ld = C; colt = (u.pn - 18) * 256; }
        else if (u.pn == 22) { base = (bf16*)(a2 + A2_K); ld = 256; colt = 0; }
        else { base = (bf16*)(a2 + A2_V); ld = 256; colt = 0; }
        const int row0 = u.pm * 256 + wr * 64 + fr, col0 = colt + wc * 32 + 8 * fq;
#pragma unroll
        for (int ai = 0; ai < 2; ++ai)
#pragma unroll
            for (int m = 0; m < 4; ++m) { bf16* rowp = base + (size_t)(row0 + ai * 128 + m * 16) * ld + col0;
#pragma unroll
                for (int bj = 0; bj < 2; ++bj) { const f32x4 v0 = acc[ai][bj][m][0], v1 = acc[ai][bj][m][1];
                    v4u w; w.x = cvt_pk_bf16(v0[0], v0[1]); w.y = cvt_pk_bf16(v0[2], v0[3]); w.z = cvt_pk_bf16(v1[0], v1[1]); w.w = cvt_pk_bf16(v1[2], v1[3]);
                    *(v4u*)(rowp + bj * 128) = w; } }
    }
};
struct EpiLora {
    static constexpr bool PERM = true;
    unsigned char* a2; unsigned char* a3;
    DI void operator()(const f32x4 (&acc)[2][2][4][2], const pg::Unit& u, int wr, int wc, int fr, int fq) const {
        const int ty = u.aux, sub = u.pn & 3;
        const int row0 = u.pm * 256 + wr * 64 + fr, colb = sub * 256 + wc * 32 + 8 * fq;
        unsigned char* pbase = ty == 0 ? a3 + (size_t)PL_W * PLANE : (ty == 1 ? a3 + (size_t)PL_B * PLANE : a2 + A2_G);
#pragma unroll
        for (int ai = 0; ai < 2; ++ai)
#pragma unroll
            for (int m = 0; m < 4; ++m) {
                const int row = row0 + ai * 128 + m * 16; const int b = row >> 14, t = row & (SEQ - 1);
#pragma unroll
                for (int bj = 0; bj < 2; ++bj) {
                    const int col = colb + bj * 128;
                    const f32x4 v0 = acc[ai][bj][m][0], v1 = acc[ai][bj][m][1];
                    const size_t sc_off = ((size_t)((b * NH + (col >> 6)) * SEQ + t) * 64 + (col & 63)) * 2;
                    v4u w; w.x = pkh2(v0[0], v0[1]); w.y = pkh2(v0[2], v0[3]); w.z = pkh2(v1[0], v1[1]); w.w = pkh2(v1[2], v1[3]); *(v4u*)(pbase + sc_off) = w;
                } }
    }
};
struct EpiPool {
    static constexpr bool PERM = true;
    bf16* O;
    DI void operator()(const f32x4 (&acc)[2][2][4][2], const pg::Unit& u, int wr, int wc, int fr, int fq) const {
        const int row0 = u.pm * 256 + wr * 64 + fr, col0 = u.pn * 256 + wc * 32 + 8 * fq;
#pragma unroll
        for (int ai = 0; ai < 2; ++ai)
#pragma unroll
            for (int m = 0; m < 4; ++m) { bf16* rowp = O + (size_t)(row0 + ai * 128 + m * 16) * C + col0;
#pragma unroll
                for (int bj = 0; bj < 2; ++bj) { const f32x4 v0 = acc[ai][bj][m][0], v1 = acc[ai][bj][m][1];
                    v4u w; w.x = cvt_pk_bf16(v0[0], v0[1]); w.y = cvt_pk_bf16(v0[2], v0[3]); w.z = cvt_pk_bf16(v1[0], v1[1]); w.w = cvt_pk_bf16(v1[2], v1[3]);
                    *(v4u*)(rowp + bj * 128) = w; } }
    }
};
struct EpiGates {
    static constexpr bool PERM = true;
    bf16* O;
    DI void operator()(const f32x4 (&acc)[2][2][4][2], const pg::Unit& u, int wr, int wc, int fr, int fq) const {
        const int row0 = u.pm * 256 + wr * 64 + fr, col0 = u.pn * 256 + wc * 32 + 8 * fq;
#pragma unroll
        for (int ai = 0; ai < 2; ++ai)
#pragma unroll
            for (int m = 0; m < 4; ++m) { bf16* rowp = O + (size_t)(row0 + ai * 128 + m * 16) * NGATE + col0;
#pragma unroll
                for (int bj = 0; bj < 2; ++bj) { const f32x4 v0 = acc[ai][bj][m][0], v1 = acc[ai][bj][m][1];
                    v4u w; w.x = cvt_pk_bf16_c(sigmoid_r(v0[0]), sigmoid_r(v0[1])); w.y = cvt_pk_bf16_c(sigmoid_r(v0[2]), sigmoid_r(v0[3]));
                    w.z = cvt_pk_bf16_c(sigmoid_r(v1[0]), sigmoid_r(v1[1])); w.w = cvt_pk_bf16_c(sigmoid_r(v1[2]), sigmoid_r(v1[3]));
                    *(v4u*)(rowp + bj * 128) = w; } }
    }
};
struct EpiBranch {
    static constexpr bool PERM = true;
    const bf16* gates; bf16* merged;
    DI void operator()(const f32x4 (&acc)[2][2][4][2], const pg::Unit& u, int wr, int wc, int fr, int fq) const {
        const int br = u.aux;
        const int row0 = u.pm * 256 + wr * 64 + fr, col0 = u.pn * 256 + wc * 32 + 8 * fq;
#pragma unroll
        for (int ai = 0; ai < 2; ++ai)
#pragma unroll
            for (int mh = 0; mh < 2; ++mh) {
                v4u gv[2][2], pv[2][2];
#pragma unroll
                for (int mm = 0; mm < 2; ++mm)
#pragma unroll
                    for (int bj = 0; bj < 2; ++bj) { const size_t row = (size_t)(row0 + ai * 128 + (2 * mh + mm) * 16); const int col = col0 + bj * 128;
                        gv[mm][bj] = *(const v4u*)(gates + row * NGATE + br * D + col);
                        pv[mm][bj] = (br == 0) ? (v4u){0u, 0u, 0u, 0u} : *(const v4u*)(merged + row * D + col); }
#pragma unroll
                for (int mm = 0; mm < 2; ++mm)
#pragma unroll
                    for (int bj = 0; bj < 2; ++bj) { const int m = 2 * mh + mm; const size_t row = (size_t)(row0 + ai * 128 + m * 16); const int col = col0 + bj * 128;
                        float g[8], p[8], o[8]; unpack_bf8(gv[mm][bj], g); unpack_bf8(pv[mm][bj], p);
                        const f32x4 v0 = acc[ai][bj][m][0], v1 = acc[ai][bj][m][1]; const float v[8] = {v0[0], v0[1], v0[2], v0[3], v1[0], v1[1], v1[2], v1[3]};
#pragma unroll
                        for (int j = 0; j < 8; ++j) o[j] = p[j] + g[j] * v[j];
                        *(v4u*)(merged + row * D + col) = pack_bf8(o); }
                asm volatile("" ::: "memory"); }
    }
};
struct EpiResid {
    static constexpr bool PERM = false;
    const float* xin; float* out;
    DI void operator()(const f32x4 (&acc)[2][2][4][2], const pg::Unit& u, int wr, int wc, int fr, int fq) const {
        const int row0 = u.pm * 256 + wr * 64 + fr, col0 = u.pn * 256 + wc * 32 + 4 * fq;
#pragma unroll
        for (int ai = 0; ai < 2; ++ai) {
            f32x4 xv[4][2][2];
#pragma unroll
            for (int m = 0; m < 4; ++m)
#pragma unroll
                for (int bj = 0; bj < 2; ++bj)
#pragma unroll
                    for (int n = 0; n < 2; ++n) xv[m][bj][n] = *(const f32x4*)(xin + (size_t)(row0 + ai * 128 + m * 16) * D + col0 + bj * 128 + n * 16);
#pragma unroll
            for (int m = 0; m < 4; ++m)
#pragma unroll
                for (int bj = 0; bj < 2; ++bj)
#pragma unroll
                    for (int n = 0; n < 2; ++n) *(f32x4*)(out + (size_t)(row0 + ai * 128 + m * 16) * D + col0 + bj * 128 + n * 16) = xv[m][bj][n] + acc[ai][bj][m][n];
            asm volatile("" ::: "memory"); }
    }
};
struct EpiRouter {
    static constexpr bool PERM = false;
    float* L;
    DI void operator()(const f32x4 (&acc)[2][2][4][2], const pg::Unit& u, int wr, int wc, int fr, int fq) const {
        if (wc >= 2) return;
        const int row0 = u.pm * 256 + wr * 64 + fr, col0 = wc * 32 + 4 * fq;
#pragma unroll
        for (int ai = 0; ai < 2; ++ai)
#pragma unroll
            for (int m = 0; m < 4; ++m) { float* rp = L + (size_t)(row0 + ai * 128 + m * 16) * 64 + col0;
#pragma unroll
                for (int n = 0; n < 2; ++n) *(f32x4*)(rp + n * 16) = acc[ai][0][m][n]; }
    }
};
struct EpiMoeUp {
    static constexpr bool PERM = true;
    bf16* HM;
    DI void operator()(const f32x4 (&acc)[2][2][4][2], const pg::Unit& u, int wr, int wc, int fr, int fq) const {
        const int row0 = u.pm * 256 + wr * 64 + fr, col0 = u.pn * 128 + wc * 32 + 8 * fq;
#pragma unroll
        for (int ai = 0; ai < 2; ++ai)
#pragma unroll
            for (int m = 0; m < 4; ++m) { bf16* rowp = HM + (size_t)(row0 + ai * 128 + m * 16) * FF + col0;
                float o[8];
#pragma unroll
                for (int n = 0; n < 2; ++n)
#pragma unroll
                    for (int j = 0; j < 4; ++j) { const float a = acc[ai][0][m][n][j], b = acc[ai][1][m][n][j]; o[n * 4 + j] = a * sigmoid_r(a) * b; }
                *(v4u*)rowp = pack_bf8(o); }
    }
};
struct EpiMoeDown {
    static constexpr bool PERM = true;
    bf16* Y2; const LAS int* rows;
    DI void operator()(const f32x4 (&acc)[2][2][4][2], const pg::Unit& u, int wr, int wc, int fr, int fq) const {
        const int col0 = u.pn * 256 + wc * 32 + 8 * fq;
#pragma unroll
        for (int ai = 0; ai < 2; ++ai)
#pragma unroll
            for (int m = 0; m < 4; ++m) { const int dest = rows[u.aux * 256 + wr * 64 + fr + ai * 128 + m * 16];
                if (dest >= 0) { bf16* rowp = Y2 + (size_t)dest * D + col0;
#pragma unroll
                    for (int bj = 0; bj < 2; ++bj) { const f32x4 v0 = acc[ai][bj][m][0], v1 = acc[ai][bj][m][1];
                        v4u w; w.x = cvt_pk_bf16(v0[0], v0[1]); w.y = cvt_pk_bf16(v0[2], v0[3]); w.z = cvt_pk_bf16(v1[0], v1[1]); w.w = cvt_pk_bf16(v1[2], v1[3]);
                        *(v4u*)(rowp + bj * 128) = w; } } }
    }
};

DI void rms_store(const f32x4 (&v)[8], const float* gain, bf16* orow, int lane) {
    float s = 0.f;
#pragma unroll
    for (int j = 0; j < 8; ++j) s += (v[j].x * v[j].x + v[j].y * v[j].y) + (v[j].z * v[j].z + v[j].w * v[j].w);
    const float rstd = __builtin_amdgcn_rsqf(wave_sum(s) * (1.0f / D) + NORM_EPS);
    GAS v2u* o8 = (GAS v2u*)orow + lane;
#pragma unroll
    for (int j = 0; j < 8; ++j) { const f32x4 g = ((const f32x4*)gain)[lane + 64 * j]; v2u w; w.x = pk2(v[j].x * rstd * g.x, v[j].y * rstd * g.y); w.y = pk2(v[j].z * rstd * g.z, v[j].w * rstd * g.w); o8[64 * j] = w; }
}
DI void moe_combine(f32x4 (&v)[8], const bf16* Y2, const float* tg, int tok, int lane) {
    const float g0 = tg[2 * tok], g1 = tg[2 * tok + 1];
    const GAS v2u* y0 = (const GAS v2u*)(Y2 + (size_t)(2 * tok) * D) + lane; const GAS v2u* y1 = (const GAS v2u*)(Y2 + (size_t)(2 * tok + 1) * D) + lane;
#pragma unroll
    for (int j = 0; j < 8; ++j) { const v2u a = y0[64 * j], b = y1[64 * j];
        v[j].x += g0 * bflo(a.x) + g1 * bflo(b.x); v[j].y += g0 * bfhi(a.x) + g1 * bfhi(b.x); v[j].z += g0 * bflo(a.y) + g1 * bflo(b.y); v[j].w += g0 * bfhi(a.y) + g1 * bfhi(b.y); }
}

struct RowIn { f32x4 x[8]; v2u y0[8], y1[8]; float g0, g1; };
DI void rowin_load(RowIn& r, const float* xsrc, const bf16* Y2, const float* tg, bool comb, int tok, int lane) {
    const GAS f32x4* xr = (const GAS f32x4*)(xsrc + (size_t)tok * D) + lane;
#pragma unroll
    for (int j = 0; j < 8; ++j) r.x[j] = xr[64 * j];
    if (comb) { r.g0 = tg[2 * tok]; r.g1 = tg[2 * tok + 1];
        const GAS v2u* y0 = (const GAS v2u*)(Y2 + (size_t)(2 * tok) * D) + lane; const GAS v2u* y1 = (const GAS v2u*)(Y2 + (size_t)(2 * tok + 1) * D) + lane;
#pragma unroll
        for (int j = 0; j < 8; ++j) { r.y0[j] = y0[64 * j]; r.y1[j] = y1[64 * j]; } }
}
DI void rowin_combine(RowIn& r) {
#pragma unroll
    for (int j = 0; j < 8; ++j) { const v2u a = r.y0[j], b = r.y1[j];
        r.x[j].x += r.g0 * bflo(a.x) + r.g1 * bflo(b.x); r.x[j].y += r.g0 * bfhi(a.x) + r.g1 * bfhi(b.x); r.x[j].z += r.g0 * bflo(a.y) + r.g1 * bflo(b.y); r.x[j].w += r.g0 * bfhi(a.y) + r.g1 * bfhi(b.y); }
}
DI void prep_block(const Frame& F, int blk, const unsigned char* a2, unsigned char* a3, unsigned char* a4, const float* mu, const float* k_k,
                   const float* qn, const float* kn, const int* positions) {
    const int lane = F.lane, t0 = blk * 16, b = t0 >> 14, tl0 = t0 & (SEQ - 1);
    const bf16* Z = (const bf16*)(a2 + A2_Z); const bf16* U = (const bf16*)(a2 + A2_U);
    v4u zprev[7];
#pragma unroll
    for (int it = 0; it < 7; ++it) { const int ci = lane + 64 * it; zprev[it] = (tl0 > 0 && ci < 440) ? *(const GAS v4u*)(Z + (size_t)(t0 - 1) * ZP + ci * 8) : (v4u){0u, 0u, 0u, 0u}; }
    float ps[2][8];
#pragma unroll
    for (int it = 0; it < 2; ++it) {
        const int ci = lane + 64 * it, m = 2 << (ci >> 5);
        v4u pr[15];
#pragma unroll
        for (int d = 1; d < 16; ++d) pr[d - 1] = (d < m && tl0 - d >= 0) ? *(const GAS v4u*)(U + (size_t)(t0 - d) * C + ci * 8) : (v4u){0u, 0u, 0u, 0u};
#pragma unroll
        for (int j = 0; j < 8; ++j) ps[it][j] = 0.f;
#pragma unroll
        for (int d = 0; d < 15; ++d) { float p[8]; unpack_bf8(pr[d], p);
#pragma unroll
            for (int j = 0; j < 8; ++j) ps[it][j] += p[j]; }
    }
    const int l = lane & 31, hw = lane >> 5;
    const float inv_freq = exp2f(-(float)l * 0.41524101186092029f);
    const float gq1 = qn[l], gq2 = qn[l + 32], gk1 = kn[l], gk2 = kn[l + 32];
#pragma unroll 1
    for (int jt = 0; jt < 16; ++jt) {
        const int tok = t0 + jt, t = tl0 + jt;
        bf16* Alora = (bf16*)(a4 + A4_LORA) + (size_t)tok * 1024;
        v4u zc[7], uc[2], uo[2];
#pragma unroll
        for (int it = 0; it < 7; ++it) { const int ci = lane + 64 * it; zc[it] = ci < 440 ? *(const GAS v4u*)(Z + (size_t)tok * ZP + ci * 8) : (v4u){0u, 0u, 0u, 0u}; }
#pragma unroll
        for (int it = 0; it < 2; ++it) { const int ci = lane + 64 * it, m = 2 << (ci >> 5);
            uc[it] = *(const GAS v4u*)(U + (size_t)tok * C + ci * 8);
            uo[it] = (t >= m - 1) ? *(const GAS v4u*)(U + (size_t)(tok - (m - 1)) * C + ci * 8) : (v4u){0u, 0u, 0u, 0u}; }
        bf16* Q = (bf16*)(a2 + A2_Q) + (size_t)tok * C; bf16* Kp = (bf16*)(a2 + A2_K) + (size_t)tok * 256;
        unsigned short x1r[10], x2r[10];
#pragma unroll
        for (int i = 0; i < 10; ++i) { const int hd = 2 * i + hw; const bf16* p = hd < 16 ? Q + hd * 64 : Kp + (hd - 16) * 64; x1r[i] = p[l]; x2r[i] = p[l + 32]; }
        const float pos = (float)positions[tok];
#pragma unroll
        for (int it = 0; it < 7; ++it) {
            const int ci = lane + 64 * it;
            if (ci < 440) {
                float cur[8], prv[8], o[8];
                unpack_bf8(zc[it], cur); unpack_bf8(zprev[it], prv);
                const f32x4 m0 = *(const f32x4*)(mu + ci * 8), m1 = *(const f32x4*)(mu + ci * 8 + 4); const float mm[8] = {m0[0], m0[1], m0[2], m0[3], m1[0], m1[1], m1[2], m1[3]};
#pragma unroll
                for (int j = 0; j < 8; ++j) o[j] = cur[j] + (prv[j] - cur[j]) * mm[j];
                if (ci < 384) {
                    const int reg = ci >> 7, hc = ci & 127;
                    const size_t sc_off = ((size_t)((b * NH + (hc >> 3)) * SEQ + t) * 64 + (hc & 7) * 8) * 2;
                    const int pl = reg == 0 ? PL_R : (reg == 1 ? PL_K : PL_V);
                    *(GAS v4u*)(a3 + (size_t)pl * PLANE + sc_off) = pack_h8(o);
                    if (reg == 1) {
                        const f32x4 q0 = *(const f32x4*)(k_k + hc * 8), q1 = *(const f32x4*)(k_k + hc * 8 + 4); const float kq[8] = {q0[0], q0[1], q0[2], q0[3], q1[0], q1[1], q1[2], q1[3]};
                        float kk[8], ss = 0.f;
#pragma unroll
                        for (int j = 0; j < 8; ++j) { kk[j] = o[j] * kq[j]; ss += kk[j] * kk[j]; }
                        ss = grp8_sum(ss);
                        const float inv = __builtin_amdgcn_rsqf(fmaxf(ss, 1e-24f));
#pragma unroll
                        for (int j = 0; j < 8; ++j) kk[j] *= inv;
                        *(GAS v4u*)(a3 + (size_t)PL_KK * PLANE + sc_off) = pack_h8(kk);
                    }
                } else if (ci < 396) {
#pragma unroll
                    for (int j = 0; j < 8; ++j) o[j] = 1.0f - 2.0f * rcpf_(1.0f + __expf(2.0f * o[j]));
                    *(GAS v4u*)(Alora + (ci - 384) * 8) = pack_bf8(o);
                } else if (ci < 408) {
                    *(GAS v4u*)(Alora + 256 + (ci - 396) * 8) = pack_bf8(o);
                } else {
#pragma unroll
                    for (int j = 0; j < 8; ++j) o[j] = sigmoid_r(o[j]);
                    *(GAS v4u*)(Alora + 512 + (ci - 408) * 8) = pack_bf8(o);
                }
            }
            zprev[it] = zc[it];
        }
        if (lane < 40) { const int cc = lane < 20 ? 96 + lane * 8 : 352 + (lane - 20) * 8; *(GAS v4u*)(Alora + cc) = (v4u){0u, 0u, 0u, 0u}; }
        {
            bf16* Ap = (bf16*)(a4 + A4_POOL) + (size_t)tok * C;
#pragma unroll
            for (int it = 0; it < 2; ++it) {
                const int ci = lane + 64 * it, m = 2 << (ci >> 5);
                const int cnt = (t + 1) < m ? (t + 1) : m;
                float cur[8], old[8], o[8];
                unpack_bf8(uc[it], cur); unpack_bf8(uo[it], old);
                const float ic = 1.0f / (float)cnt;
#pragma unroll
                for (int j = 0; j < 8; ++j) { const float sw = ps[it][j] + cur[j]; o[j] = sw * ic - cur[j]; ps[it][j] = sw - old[j]; }
                *(GAS v4u*)(Ap + ci * 8) = pack_bf8(o);
            }
        }
        {
            float sn, cs; sincosf(pos * inv_freq, &sn, &cs);
#pragma unroll
            for (int i = 0; i < 10; ++i) {
                const int hd = 2 * i + hw; const bool isq = hd < 16;
                bf16* p = isq ? Q + hd * 64 : Kp + (hd - 16) * 64;
                float x1 = bflo((unsigned)x1r[i]), x2 = bflo((unsigned)x2r[i]);
                float ss = x1 * x1 + x2 * x2;
                ss = grp32_sum(ss);
                const float rs = __builtin_amdgcn_rsqf(ss * (1.0f / 64.0f) + NORM_EPS);
                x1 = x1 * rs * (isq ? gq1 : gk1); x2 = x2 * rs * (isq ? gq2 : gk2);
                const float o1 = x1 * cs - x2 * sn, o2 = x2 * cs + x1 * sn;
                p[l] = (bf16)f2bf(o1); p[l + 32] = (bf16)f2bf(o2);
            }
        }
    }
}

struct FinIn { v4u w[2], a[2], k[2], kk[2]; };
DI size_t sc_off_of(int tok, int ci) { const int b = tok >> 14, t = tok & (SEQ - 1); return ((size_t)((b * NH + (ci >> 3)) * SEQ + t) * 64 + (ci & 7) * 8) * 2; }
DI void fin_load(FinIn& f, const unsigned char* a3, int tok, int lane) {
#pragma unroll
    for (int it = 0; it < 2; ++it) { const size_t o = sc_off_of(tok, lane + 64 * it);
        f.w[it] = *(const GAS v4u*)(a3 + (size_t)PL_W * PLANE + o); f.a[it] = *(const GAS v4u*)(a3 + (size_t)PL_B * PLANE + o);
        f.k[it] = *(const GAS v4u*)(a3 + (size_t)PL_K * PLANE + o); f.kk[it] = *(const GAS v4u*)(a3 + (size_t)PL_KK * PLANE + o); }
}
DI void fin_body(const FinIn& cur, int m, int lane, unsigned char* a3, const float (&pw)[2][8], const float (&pa)[2][8], const float (&ka)[2][8]) {
#pragma unroll
    for (int it = 0; it < 2; ++it) {
        const size_t o = sc_off_of(m, lane + 64 * it);
        float wr_[8], ar_[8], ks[8], kk[8], wo[8], ko[8], bo[8];
        unpack_h8(cur.w[it], wr_); unpack_h8(cur.a[it], ar_); unpack_h8(cur.k[it], ks); unpack_h8(cur.kk[it], kk);
#pragma unroll
        for (int j = 0; j < 8; ++j) {
            wo[j] = __expf(-0.6065306597f * sigmoidf_(pw[it][j] + wr_[j]));
            const float a = sigmoidf_(pa[it][j] + ar_[j]);
            ko[j] = ks[j] * (1.0f + (a - 1.0f) * ka[it][j]); bo[j] = kk[j] * a; }
        *(GAS v4u*)(a3 + (size_t)PL_W * PLANE + o) = pack_h8(wo); *(GAS v4u*)(a3 + (size_t)PL_K * PLANE + o) = pack_h8(ko); *(GAS v4u*)(a3 + (size_t)PL_B * PLANE + o) = pack_h8(bo);
    }
}
DI void finalize_phase(const Frame& F, unsigned char* a3, const float* w0, const float* a0, const float* k_a) {
    const int lane = F.lane;
    float pw[2][8], pa[2][8], ka[2][8];
#pragma unroll
    for (int it = 0; it < 2; ++it) { const int ci = lane + 64 * it;
        const f32x4 p0 = *(const f32x4*)(w0 + ci * 8), p1 = *(const f32x4*)(w0 + ci * 8 + 4), q0 = *(const f32x4*)(a0 + ci * 8), q1 = *(const f32x4*)(a0 + ci * 8 + 4), r0 = *(const f32x4*)(k_a + ci * 8), r1 = *(const f32x4*)(k_a + ci * 8 + 4);
#pragma unroll
        for (int j = 0; j < 4; ++j) { pw[it][j] = p0[j]; pw[it][4 + j] = p1[j]; pa[it][j] = q0[j]; pa[it][4 + j] = q1[j]; ka[it][j] = r0[j]; ka[it][4 + j] = r1[j]; } }
#pragma unroll 1
    for (int m = F.gw; m < NT; m += 2 * F.NGW) {
        const int m1 = m + F.NGW; const bool has1 = m1 < NT;
        FinIn fa, fb;
        fin_load(fa, a3, m, lane); fin_load(fb, a3, has1 ? m1 : m, lane);
        fin_body(fa, m, lane, a3, pw, pa, ka);
        if (has1) fin_body(fb, m1, lane, a3, pw, pa, ka);
    }
}

DI void postscan_phase(const Frame& F, unsigned char* a2, const unsigned char* a3, const float* ln_g, const float* ln_b, const float* bonus) {
    const int lane = F.lane;
    float lg[2][8], lb[2][8];
#pragma unroll
    for (int it = 0; it < 2; ++it) { const int ci = lane + 64 * it;
        const f32x4 q0 = *(const f32x4*)(ln_g + ci * 8), q1 = *(const f32x4*)(ln_g + ci * 8 + 4), r0 = *(const f32x4*)(ln_b + ci * 8), r1 = *(const f32x4*)(ln_b + ci * 8 + 4);
#pragma unroll
        for (int j = 0; j < 4; ++j) { lg[it][j] = q0[j]; lg[it][4 + j] = q1[j]; lb[it][j] = r0[j]; lb[it][4 + j] = r1[j]; } }
#pragma unroll 1
    for (int qd = F.gw; qd < NT / 4; qd += F.NGW) {
        const int tok0 = qd * 4, b = tok0 >> 14, t0 = tok0 & (SEQ - 1);
        v4u yq[2][4], vv[2][4], gg[2][4]; float bn[2][4];
#pragma unroll
        for (int it = 0; it < 2; ++it) { const int ci = lane + 64 * it, chain = b * NH + (ci >> 3);
            const GAS v4u* yp = (const GAS v4u*)(a2 + A2_Y + (((size_t)chain * (SEQ / 4) + (t0 >> 2)) * 64 + (ci & 7) * 8) * 8);
#pragma unroll
            for (int k4 = 0; k4 < 4; ++k4) yq[it][k4] = yp[k4];
#pragma unroll
            for (int tt = 0; tt < 4; ++tt) { const size_t o = sc_off_of(tok0 + tt, ci);
                vv[it][tt] = *(const GAS v4u*)(a3 + (size_t)PL_V * PLANE + o); gg[it][tt] = *(const GAS v4u*)(a2 + A2_G + o);
                bn[it][tt] = bonus[(size_t)chain * SEQ + t0 + tt]; } }
#pragma unroll
        for (int it = 0; it < 2; ++it) {
            const int ci = lane + 64 * it;
            const unsigned yw[16] = {yq[it][0].x, yq[it][0].y, yq[it][0].z, yq[it][0].w, yq[it][1].x, yq[it][1].y, yq[it][1].z, yq[it][1].w,
                                     yq[it][2].x, yq[it][2].y, yq[it][2].z, yq[it][2].w, yq[it][3].x, yq[it][3].y, yq[it][3].z, yq[it][3].w};
#pragma unroll
            for (int tt = 0; tt < 4; ++tt) {
                float y[8], v[8], g[8], o[8];
#pragma unroll
                for (int j = 0; j < 8; ++j) { const unsigned w = yw[2 * j + (tt >> 1)]; y[j] = (tt & 1) ? bfhi(w) : bflo(w); }
                unpack_h8(vv[it][tt], v); unpack_h8(gg[it][tt], g);
                float s1 = 0.f;
#pragma unroll
                for (int j = 0; j < 8; ++j) s1 += y[j];
                s1 = grp8_sum(s1);
                const float mean = s1 * (1.0f / 64.0f); float s2 = 0.f;
#pragma unroll
                for (int j = 0; j < 8; ++j) { const float d = y[j] - mean; s2 += d * d; }
                s2 = grp8_sum(s2);
                const float rstd = __builtin_amdgcn_rsqf(s2 * (1.0f / 64.0f) + GN_EPS);
#pragma unroll
                for (int j = 0; j < 8; ++j) o[j] = ((y[j] - mean) * rstd * lg[it][j] + lb[it][j] + bn[it][tt] * v[j]) * g[j];
                *(GAS v4u*)(a2 + A2_AOUT + ((size_t)(tok0 + tt) * C + ci * 8) * 2) = pack_bf8(o);
            }
        }
    }
}

DI float ar16(float x) {
    x += __builtin_bit_cast(float, __builtin_amdgcn_update_dpp(0, __builtin_bit_cast(int, x), 0x128, 0xf, 0xf, false));
    x += __builtin_bit_cast(float, __builtin_amdgcn_update_dpp(0, __builtin_bit_cast(int, x), 0x124, 0xf, 0xf, false));
    x += __builtin_bit_cast(float, __builtin_amdgcn_update_dpp(0, __builtin_bit_cast(int, x), 0x122, 0xf, 0xf, false));
    x += __builtin_bit_cast(float, __builtin_amdgcn_update_dpp(0, __builtin_bit_cast(int, x), 0x121, 0xf, 0xf, false));
    return x;
}
constexpr int SCAN_TB = 32, SCAN_BUF = 6 * SCAN_TB * 128;
DI void scan_stage(const unsigned char* a3, size_t gofs, LAS unsigned char* buf, int tid, int wave) {
#pragma unroll
    for (int r = 0; r < 3; ++r) { const int o = (r * 512 + tid) * 16; const int pl = o >> 12, within = o & 4095;
        __builtin_amdgcn_global_load_lds((const unsigned*)(a3 + (size_t)pl * PLANE + gofs + within), (LAS unsigned*)(buf + r * 8192 + wave * 1024), 16, 0, 0); }
}
struct ScanOp { v2u r, w, k, kk, b; unsigned v; };
DI void scan_ld(ScanOp& o, const LAS unsigned char* cb, int j, int o4, int ov) {
    o.kk = *(const LAS v2u*)(cb + PL_KK * 4096 + j * 128 + o4); o.w = *(const LAS v2u*)(cb + PL_W * 4096 + j * 128 + o4); o.k = *(const LAS v2u*)(cb + PL_K * 4096 + j * 128 + o4);
    o.b = *(const LAS v2u*)(cb + PL_B * 4096 + j * 128 + o4); o.r = *(const LAS v2u*)(cb + PL_R * 4096 + j * 128 + o4); o.v = (unsigned)*(const LAS unsigned short*)(cb + PL_V * 4096 + j * 128 + ov);
}
DI void scan_step(float& s0, float& s1, float& s2, float& s3, float& y, float& yp, const ScanOp& c) {
    float d, t0, t1, t2, t3;
    asm("v_fma_mix_f32 %[d], %[s0], %[kkx], 0 op_sel:[0,0,0] op_sel_hi:[0,1,0]\n\t"
        "v_add_f32_dpp %[y], %[y], %[y] row_ror:8 row_mask:0xf bank_mask:0xf\n\t"
        "v_fma_mix_f32 %[d], %[s1], %[kkx], %[d] op_sel:[0,1,0] op_sel_hi:[0,1,0]\n\t"
        "v_fma_mix_f32 %[d], %[s2], %[kky], %[d] op_sel:[0,0,0] op_sel_hi:[0,1,0]\n\t"
        "v_add_f32_dpp %[y], %[y], %[y] row_ror:4 row_mask:0xf bank_mask:0xf\n\t"
        "v_fma_mix_f32 %[d], %[s3], %[kky], %[d] op_sel:[0,1,0] op_sel_hi:[0,1,0]\n\t"
        "v_fma_mix_f32 %[t0], %[v], %[kx], 0 op_sel:[0,0,0] op_sel_hi:[1,1,0]\n\t"
        "v_add_f32_dpp %[y], %[y], %[y] row_ror:2 row_mask:0xf bank_mask:0xf\n\t"
        "v_fma_mix_f32 %[t1], %[v], %[kx], 0 op_sel:[0,1,0] op_sel_hi:[1,1,0]\n\t"
        "v_fma_mix_f32 %[t2], %[v], %[ky], 0 op_sel:[0,0,0] op_sel_hi:[1,1,0]\n\t"
        "v_add_f32_dpp %[y], %[y], %[y] row_ror:1 row_mask:0xf bank_mask:0xf\n\t"
        "v_add_f32_dpp %[d], %[d], %[d] row_ror:8 row_mask:0xf bank_mask:0xf\n\t"
        "v_fma_mix_f32 %[t3], %[v], %[ky], 0 op_sel:[0,1,0] op_sel_hi:[1,1,0]\n\t"
        "v_fma_mix_f32 %[t0], %[s0], %[wx], %[t0] op_sel:[0,0,0] op_sel_hi:[0,1,0]\n\t"
        "v_add_f32_dpp %[d], %[d], %[d] row_ror:4 row_mask:0xf bank_mask:0xf\n\t"
        "v_fma_mix_f32 %[t1], %[s1], %[wx], %[t1] op_sel:[0,1,0] op_sel_hi:[0,1,0]\n\t"
        "v_fma_mix_f32 %[t2], %[s2], %[wy], %[t2] op_sel:[0,0,0] op_sel_hi:[0,1,0]\n\t"
        "v_add_f32_dpp %[d], %[d], %[d] row_ror:2 row_mask:0xf bank_mask:0xf\n\t"
        "v_fma_mix_f32 %[t3], %[s3], %[wy], %[t3] op_sel:[0,1,0] op_sel_hi:[0,1,0]\n\t"
        "s_nop 0\n\t"
        "v_add_f32_dpp %[d], %[d], %[d] row_ror:1 row_mask:0xf bank_mask:0xf\n\t"
        "v_fma_mix_f32 %[s0], -%[d], %[bx], %[t0] op_sel:[0,0,0] op_sel_hi:[0,1,0]\n\t"
        "v_fma_mix_f32 %[s1], -%[d], %[bx], %[t1] op_sel:[0,1,0] op_sel_hi:[0,1,0]\n\t"
        "v_fma_mix_f32 %[s2], -%[d], %[by], %[t2] op_sel:[0,0,0] op_sel_hi:[0,1,0]\n\t"
        "v_fma_mix_f32 %[s3], -%[d], %[by], %[t3] op_sel:[0,1,0] op_sel_hi:[0,1,0]\n\t"
        "v_fma_mix_f32 %[yp], %[s0], %[rx], 0 op_sel:[0,0,0] op_sel_hi:[0,1,0]\n\t"
        "v_fma_mix_f32 %[yp], %[s1], %[rx], %[yp] op_sel:[0,1,0] op_sel_hi:[0,1,0]\n\t"
        "v_fma_mix_f32 %[yp], %[s2], %[ry], %[yp] op_sel:[0,0,0] op_sel_hi:[0,1,0]\n\t"
        "v_fma_mix_f32 %[yp], %[s3], %[ry], %[yp] op_sel:[0,1,0] op_sel_hi:[0,1,0]\n\t"
        "s_nop 1"
        : [s0] "+v"(s0), [s1] "+v"(s1), [s2] "+v"(s2), [s3] "+v"(s3), [y] "+v"(y), [yp] "=&v"(yp), [d] "=&v"(d), [t0] "=&v"(t0), [t1] "=&v"(t1), [t2] "=&v"(t2), [t3] "=&v"(t3)
        : [kkx] "v"(c.kk.x), [kky] "v"(c.kk.y), [wx] "v"(c.w.x), [wy] "v"(c.w.y), [kx] "v"(c.k.x), [ky] "v"(c.k.y), [bx] "v"(c.b.x), [by] "v"(c.b.y), [rx] "v"(c.r.x), [ry] "v"(c.r.y), [v] "v"(c.v));
}
DI void scan_chain(const Frame& F, int s, const unsigned char* a3, unsigned char* a2) {
    const int lane = F.lane, chain = s >> 2, row = 16 * (s & 3) + 4 * (F.wave & 3) + (lane >> 4), ki = lane & 15;
    const bool worker = F.wave < 4;
    float S0 = 0.f, S1 = 0.f, S2 = 0.f, S3 = 0.f, ycar = 0.f;
    GAS bf16* Y = (GAS bf16*)(a2 + A2_Y) + (size_t)chain * SEQ * 64 + row;
    const size_t g0 = (size_t)chain * SEQ * 128;
    LAS unsigned char* lbuf = F.lds;
    const int o4 = ki * 8, ov = row * 2;
    scan_stage(a3, g0, lbuf, F.tid, F.wave);
    asm volatile("s_waitcnt vmcnt(0)" ::: "memory"); __syncthreads();
#pragma unroll 1
    for (int blk = 0; blk < SEQ / SCAN_TB; ++blk) {
        const LAS unsigned char* cb = lbuf + (blk & 1) * SCAN_BUF;
        if (blk + 1 < SEQ / SCAN_TB) scan_stage(a3, g0 + (size_t)(blk + 1) * SCAN_TB * 128, lbuf + ((blk + 1) & 1) * SCAN_BUF, F.tid, F.wave);
        if (worker) {
            float yk0 = 0.f, yk1 = 0.f;
            ScanOp op[3];
            scan_ld(op[0], cb, 0, o4, ov); scan_ld(op[1], cb, 1, o4, ov);
#pragma unroll
            for (int j = 0; j < SCAN_TB; ++j) {
                if (j + 2 < SCAN_TB) scan_ld(op[(j + 2) % 3], cb, j + 2, o4, ov);
                asm volatile("" ::: "memory");
                float yp; scan_step(S0, S1, S2, S3, ycar, yp, op[j % 3]);
                if (j < 16) yk0 = (ki == j) ? ycar : yk0; else yk1 = (ki == j - 16) ? ycar : yk1;
                ycar = yp;
            }
            if (blk > 0 || ki > 0) Y[(long)(blk * SCAN_TB - 1 + ki) * 64] = (bf16)f2bf(yk0);
            Y[(size_t)(blk * SCAN_TB + 15 + ki) * 64] = (bf16)f2bf(yk1);
        }
        asm volatile("s_waitcnt vmcnt(0)" ::: "memory"); __syncthreads();
    }
    if (worker) { const float yl = ar16(ycar); if (ki == 0) Y[(size_t)(SEQ - 1) * 64] = (bf16)f2bf(yl); }
}

typedef _Float16 h16x8 __attribute__((ext_vector_type(8)));
DI s16x4 tr_read(unsigned lds_addr);
#define MFMA16H(a, b, c) __builtin_amdgcn_mfma_f32_16x16x32_f16((a), (b), (c), 0, 0, 0)
constexpr int CH_L = 16, CH_NSEG = 8, CH_SEGCH = 128;
constexpr int SC_AG = 0, SC_RG = 2048, SC_BG = 4096, SC_KG = 6144, SC_AP = 8192, SC_ZT = 10240, SC_WT = 12288, SC_AK = 12800, SC_ABT = 13312, SC_RB = 14336, SC_RK = 15360, SC_BYTES = 16384;
DI void tr_frag4(unsigned base, int k0, int i16, h16x8& fa, h16x8& fr, h16x8& fb, h16x8& fk) {
    const unsigned a0 = base + (unsigned)(k0 + (i16 >> 2)) * 32u + 8u * (i16 & 3), a1 = a0 + 128u;
    s16x4 l0, h0, l1, h1, l2, h2, l3, h3;
    asm volatile("ds_read_b64_tr_b16 %0, %8\n\tds_read_b64_tr_b16 %1, %9\n\tds_read_b64_tr_b16 %2, %8 offset:2048\n\tds_read_b64_tr_b16 %3, %9 offset:2048\n\t"
                 "ds_read_b64_tr_b16 %4, %8 offset:4096\n\tds_read_b64_tr_b16 %5, %9 offset:4096\n\tds_read_b64_tr_b16 %6, %8 offset:6144\n\tds_read_b64_tr_b16 %7, %9 offset:6144\n\ts_waitcnt lgkmcnt(0)"
                 : "=&v"(l0), "=&v"(h0), "=&v"(l1), "=&v"(h1), "=&v"(l2), "=&v"(h2), "=&v"(l3), "=&v"(h3) : "v"(a0), "v"(a1) : "memory");
    fa = __builtin_bit_cast(h16x8, __builtin_shufflevector(l0, h0, 0, 1, 2, 3, 4, 5, 6, 7)); fr = __builtin_bit_cast(h16x8, __builtin_shufflevector(l1, h1, 0, 1, 2, 3, 4, 5, 6, 7));
    fb = __builtin_bit_cast(h16x8, __builtin_shufflevector(l2, h2, 0, 1, 2, 3, 4, 5, 6, 7)); fk = __builtin_bit_cast(h16x8, __builtin_shufflevector(l3, h3, 0, 1, 2, 3, 4, 5, 6, 7));
}
DI v4u pack16h(const float (&x)[16], int o) { v4u w; w.x = pkh2(x[o], x[o + 1]); w.y = pkh2(x[o + 2], x[o + 3]); w.z = pkh2(x[o + 4], x[o + 5]); w.w = pkh2(x[o + 6], x[o + 7]); return w; }
DI v4u packt(const f32x4& a, const f32x4& b) { v4u p; p.x = pkh2(a[0], a[1]); p.y = pkh2(a[2], a[3]); p.z = pkh2(b[0], b[1]); p.w = pkh2(b[2], b[3]); return p; }
DI void wt16(__amdgpu_buffer_rsrc_t r, int off, v4u v) { __builtin_amdgcn_raw_buffer_store_b128(v, r, off, 0, 16); }
DI void wt8(__amdgpu_buffer_rsrc_t r, int off, v2u v) { __builtin_amdgcn_raw_buffer_store_b64(v, r, off, 0, 16); }
DI v4u ld16(__amdgpu_buffer_rsrc_t r, int off) { return __builtin_amdgcn_raw_buffer_load_b128(r, off, 0, 16); }
template <int ROLE>
DI void chunkA_unit(int lane, int chain, int chunk, const unsigned char* a3, __amdgpu_buffer_rsrc_t fdst, LAS unsigned char* sc,
                        const float* w0, const float* a0, const float* k_a, const float* r_k, float* bonus, v4u (&A1P)[3][2], LAS unsigned char* park, LAS unsigned char* park2) {
    asm volatile("" : "+v"(lane));
    const size_t row0 = ((size_t)chain * SEQ + (size_t)chunk * CH_L) * 64;
    const int q = lane >> 4, n = lane & 15;
    float z[16];
    float g7, g15;
    {
#pragma unroll
        for (int pl = 0; pl < 6; ++pl)
#pragma unroll
            for (int hf = 0; hf < 2; ++hf)
                if (pl != PL_V) __builtin_amdgcn_global_load_lds((const unsigned*)(a3 + (size_t)pl * PLANE + row0 * 2 + hf * 1024 + lane * 16), (LAS unsigned*)(sc + pl * 2048 + hf * 1024), 16, 0, 0);
        asm volatile("s_waitcnt vmcnt(0)" ::: "memory");
        const int cg = (chain & (NH - 1)) * 64 + lane;
        const float pw0 = w0[cg], pa0 = a0[cg], pka = k_a[cg], prk = r_k[cg];
        float gi[16], fk[16];
        { float g = 1.f;
#pragma unroll
          for (int i = 0; i < 16; ++i) { g *= __expf(-0.6065306597f * sigmoid_r(pw0 + (float)*(const LAS f16*)(sc + PL_W * 2048 + i * 128 + lane * 2))); gi[i] = g; } }
        asm volatile("" ::: "memory");
        g7 = gi[7]; g15 = gi[15];
        const float ig7 = rcpf_(g7);
        v4u agp[2], app[2], bgp[2];
#pragma unroll
        for (int h = 0; h < 2; ++h) {
            float ag[8], ap[8], bg[8];
#pragma unroll
            for (int j = 0; j < 8; ++j) { const int i = 8 * h + j;
                const float kkx = (float)*(const LAS f16*)(sc + PL_KK * 2048 + i * 128 + lane * 2), a = sigmoid_r(pa0 + (float)*(const LAS f16*)(sc + PL_B * 2048 + i * 128 + lane * 2));
                fk[i] = 1.0f + (a - 1.0f) * pka;
                const float bx = kkx * a, gp = i ? gi[i - 1] : 1.0f, ig = rcpf_(gi[i]);
                ap[j] = -kkx * gp; ag[j] = ap[j] * ig7; bg[j] = bx * (g7 * ig); z[i] = bx * (g15 * ig); }
            agp[h].x = pkh2(ag[0], ag[1]); agp[h].y = pkh2(ag[2], ag[3]); agp[h].z = pkh2(ag[4], ag[5]); agp[h].w = pkh2(ag[6], ag[7]);
            app[h].x = pkh2(ap[0], ap[1]); app[h].y = pkh2(ap[2], ap[3]); app[h].z = pkh2(ap[4], ap[5]); app[h].w = pkh2(ap[6], ap[7]);
            bgp[h].x = pkh2(bg[0], bg[1]); bgp[h].y = pkh2(bg[2], bg[3]); bgp[h].z = pkh2(bg[4], bg[5]); bgp[h].w = pkh2(bg[6], bg[7]);
            asm volatile("" ::: "memory");
        }
        float kv[16], rv[16];
#pragma unroll
        for (int i = 0; i < 16; ++i) { kv[i] = (float)*(const LAS f16*)(sc + PL_K * 2048 + i * 128 + lane * 2); rv[i] = (float)*(const LAS f16*)(sc + PL_R * 2048 + i * 128 + lane * 2); }
        asm volatile("s_waitcnt lgkmcnt(0)" ::: "memory");
        *(LAS v4u*)(sc + SC_AG + lane * 32) = agp[0]; *(LAS v4u*)(sc + SC_AG + lane * 32 + 16) = agp[1];
        *(LAS v4u*)(sc + SC_AP + lane * 32) = app[0]; *(LAS v4u*)(sc + SC_AP + lane * 32 + 16) = app[1];
        *(LAS v4u*)(sc + SC_BG + lane * 32) = bgp[0]; *(LAS v4u*)(sc + SC_BG + lane * 32 + 16) = bgp[1];
#pragma unroll
        for (int i = 0; i < 16; ++i) { rv[i] = rv[i] * gi[i] * ig7; kv[i] = kv[i] * fk[i] * (g7 * rcpf_(gi[i])); }
        *(LAS v4u*)(sc + SC_RG + lane * 32) = pack16h(rv, 0); *(LAS v4u*)(sc + SC_RG + lane * 32 + 16) = pack16h(rv, 8);
        *(LAS v4u*)(sc + SC_KG + lane * 32) = pack16h(kv, 0); *(LAS v4u*)(sc + SC_KG + lane * 32 + 16) = pack16h(kv, 8);
#pragma unroll
        for (int i = 0; i < 16; ++i) rv[i] *= prk;
        *(LAS v4u*)(sc + SC_ZT + lane * 32) = pack16h(rv, 0); *(LAS v4u*)(sc + SC_ZT + lane * 32 + 16) = pack16h(rv, 8);
    }
    asm volatile("s_waitcnt lgkmcnt(0)" ::: "memory");
    const unsigned sb = (unsigned)(size_t)sc;
    {
        f32x4 gab = {0.f, 0.f, 0.f, 0.f}, gak = gab, grb = gab, grk = gab, gbn = gab;
#pragma unroll
        for (int s2 = 0; s2 < 2; ++s2) {
            const int k0 = 32 * s2 + 8 * q;
            h16x8 fa, fr, fb, fk; tr_frag4(sb + SC_AG, k0, n, fa, fr, fb, fk);
            gab = MFMA16H(fb, fa, gab);
            gak = MFMA16H(fk, fa, gak);
            grb = MFMA16H(fr, fb, grb);
            grk = MFMA16H(fr, fk, grk);
            { const unsigned zb = sb + SC_ZT + (unsigned)(k0 + (n >> 2)) * 32u + 8u * (n & 3); s16x4 bl, bh;
              asm volatile("ds_read_b64_tr_b16 %0, %2\n\tds_read_b64_tr_b16 %1, %2 offset:128\n\ts_waitcnt lgkmcnt(0)" : "=&v"(bl), "=&v"(bh) : "v"(zb) : "memory");
              gbn = MFMA16H(__builtin_bit_cast(h16x8, __builtin_shufflevector(bl, bh, 0, 1, 2, 3, 4, 5, 6, 7)), fk, gbn); }
        }
        if ((n >> 2) == q) bonus[(size_t)chain * SEQ + (size_t)chunk * CH_L + n] = gbn[n & 3];
#pragma unroll
        for (int r4 = 0; r4 < 4; ++r4) { const int rr = 4 * q + r4;
            *(LAS float*)(sc + SC_ABT + (rr * 16 + n) * 4) = (n > rr) ? gab[r4] : 0.f;
            *(LAS f16*)(sc + SC_AK + (rr * 16 + n) * 2) = (f16)((n > rr) ? gak[r4] : 0.f);
            *(LAS float*)(sc + SC_RB + (rr * 16 + n) * 4) = (n <= rr) ? grb[r4] : 0.f;
            *(LAS float*)(sc + SC_RK + (rr * 16 + n) * 4) = (n <= rr) ? grk[r4] : 0.f; }
        *(LAS float*)(sc + SC_AG + lane * 4) = g7; *(LAS float*)(sc + SC_AG + 256 + lane * 4) = g15; *(LAS float*)(sc + SC_AG + 512 + lane * 4) = g15 * rcpf_(g7);
    }
    asm volatile("s_waitcnt lgkmcnt(0)" ::: "memory");
    {
        float wv[16];
#pragma unroll
        for (int i4 = 0; i4 < 4; ++i4) { const f32x4 t4 = *(const LAS f32x4*)(sc + SC_RB + (n * 16 + 4 * i4) * 4); wv[4 * i4] = t4[0]; wv[4 * i4 + 1] = t4[1]; wv[4 * i4 + 2] = t4[2]; wv[4 * i4 + 3] = t4[3]; }
#pragma unroll
        for (int i = 14; i >= 0; --i) {
            if (ROLE == 1 && (i % 4) == 2) asm volatile("" ::: "memory");
            float c[16];
#pragma unroll
            for (int j4 = (i + 1) / 4; j4 < 4; ++j4) { const f32x4 t4 = *(const LAS f32x4*)(sc + SC_ABT + (i * 16 + 4 * j4) * 4); c[4 * j4] = t4[0]; c[4 * j4 + 1] = t4[1]; c[4 * j4 + 2] = t4[2]; c[4 * j4 + 3] = t4[3]; }
#pragma unroll
            for (int j = i + 1; j < 16; ++j) { z[i] = __builtin_fmaf(c[j], z[j], z[i]); wv[i] = __builtin_fmaf(c[j], wv[j], wv[i]); }
        }
        *(LAS v4u*)(sc + SC_ZT + lane * 32) = pack16h(z, 0); *(LAS v4u*)(sc + SC_ZT + lane * 32 + 16) = pack16h(z, 8);
        if (lane < 16) { *(LAS v4u*)(sc + SC_WT + lane * 32) = pack16h(wv, 0); *(LAS v4u*)(sc + SC_WT + lane * 32 + 16) = pack16h(wv, 8); }
    }
    asm volatile("s_waitcnt lgkmcnt(0)" ::: "memory");
    {
        const v4u zero4 = {0u, 0u, 0u, 0u};
        h16x8 apF[4], zF[4], wF, akF;
#pragma unroll
        for (int m4 = 0; m4 < 4; ++m4) {
            apF[m4] = __builtin_bit_cast(h16x8, q < 2 ? *(const LAS v4u*)(sc + SC_AP + (16 * m4 + n) * 32 + 16 * q) : zero4);
            zF[m4] = __builtin_bit_cast(h16x8, q < 2 ? *(const LAS v4u*)(sc + SC_ZT + (16 * m4 + n) * 32 + 16 * q) : zero4); }
        wF = __builtin_bit_cast(h16x8, q < 2 ? *(const LAS v4u*)(sc + SC_WT + n * 32 + 16 * q) : zero4);
        akF = __builtin_bit_cast(h16x8, q < 2 ? *(const LAS v4u*)(sc + SC_AK + n * 32 + 16 * q) : zero4);
        const f32x4 z4 = {0.f, 0.f, 0.f, 0.f};
        f32x4 py[4];
#pragma unroll
        for (int m4 = 0; m4 < 4; ++m4) { f32x4 init;
#pragma unroll
            for (int r4 = 0; r4 < 4; ++r4) { const int kc = 16 * m4 + 4 * q + r4; init[r4] = (float)*(const LAS f16*)(sc + SC_RG + kc * 32 + n * 2) * *(const LAS float*)(sc + SC_AG + kc * 4); }
            py[m4] = MFMA16H(apF[m4], wF, init); }
        f32x4 qy = *(const LAS f32x4*)(sc + SC_RK + (n * 16 + 4 * q) * 4);
        qy = MFMA16H(akF, wF, qy);
        if constexpr (ROLE == 0) {
            wt16(fdst, 12 * 1024 + lane * 16, packt(py[0], py[1])); wt16(fdst, 13 * 1024 + lane * 16, packt(py[2], py[3]));
            { v4u o; o.x = pkh2(qy[0], qy[1]); o.y = pkh2(qy[2], qy[3]); o.z = 0u; o.w = 0u; wt16(fdst, 14 * 1024 + lane * 16, o); }
#pragma unroll
            for (int nt = 0; nt < 4; ++nt) {
                const float g15c = *(const LAS float*)(sc + SC_AG + 256 + (16 * nt + n) * 4);
                f32x4 t[4];
#pragma unroll
                for (int mt = 0; mt < 4; ++mt) { f32x4 init = z4;
                    if (mt == nt) {
#pragma unroll
                        for (int r4 = 0; r4 < 4; ++r4) init[r4] = (4 * q + r4 == n) ? g15c : 0.f; }
                    t[mt] = MFMA16H(zF[mt], apF[nt], init); }
                if (nt < 3) { A1P[nt][0] = packt(t[0], t[1]); A1P[nt][1] = packt(t[2], t[3]); } else { *(LAS v4u*)(park2 + lane * 16) = packt(t[0], t[1]); *(LAS v4u*)(park2 + 1024 + lane * 16) = packt(t[2], t[3]); }
            }
            f32x4 qt[4];
#pragma unroll
            for (int mt = 0; mt < 4; ++mt) { f32x4 init;
#pragma unroll
                for (int r4 = 0; r4 < 4; ++r4) { const int kc = 16 * mt + 4 * q + r4; init[r4] = (float)*(const LAS f16*)(sc + SC_KG + kc * 32 + n * 2) * *(const LAS float*)(sc + SC_AG + 512 + kc * 4); }
                qt[mt] = MFMA16H(zF[mt], akF, init); }
            *(LAS v4u*)(park + lane * 16) = packt(qt[0], qt[1]); *(LAS v4u*)(park + 1024 + lane * 16) = packt(qt[2], qt[3]);
        } else {
            { const h16x8 b0 = __builtin_bit_cast(h16x8, packt(py[0], py[1])), b1 = __builtin_bit_cast(h16x8, packt(py[2], py[3]));
              f32x4 pp[4];
#pragma unroll
              for (int nt = 0; nt < 4; ++nt) { pp[nt] = MFMA16H(__builtin_bit_cast(h16x8, nt < 3 ? A1P[nt][0] : *(const LAS v4u*)(park2 + lane * 16)), b0, z4); pp[nt] = MFMA16H(__builtin_bit_cast(h16x8, nt < 3 ? A1P[nt][1] : *(const LAS v4u*)(park2 + 1024 + lane * 16)), b1, pp[nt]); }
              f32x4 qp = MFMA16H(__builtin_bit_cast(h16x8, *(const LAS v4u*)(park + lane * 16)), b0, z4); qp = MFMA16H(__builtin_bit_cast(h16x8, *(const LAS v4u*)(park + 1024 + lane * 16)), b1, qp);
              wt16(fdst, 15 * 1024 + lane * 16, packt(pp[0], pp[1])); wt16(fdst, 16 * 1024 + lane * 16, packt(pp[2], pp[3]));
              wt16(fdst, 17 * 1024 + lane * 16, packt(qp, qy)); }
#pragma unroll
            for (int mt = 0; mt < 4; ++mt) {
                const float g15c = *(const LAS float*)(sc + SC_AG + 256 + (16 * mt + n) * 4), rat = *(const LAS float*)(sc + SC_AG + 512 + (16 * mt + n) * 4);
                f32x4 ps[4];
#pragma unroll
                for (int m4 = 0; m4 < 4; ++m4) { f32x4 init = z4;
                    if (m4 == mt) {
#pragma unroll
                        for (int r4 = 0; r4 < 4; ++r4) init[r4] = (4 * q + r4 == n) ? g15c : 0.f; }
                    ps[m4] = MFMA16H(apF[m4], zF[mt], init); }
                const h16x8 b0 = __builtin_bit_cast(h16x8, packt(ps[0], ps[1])), b1 = __builtin_bit_cast(h16x8, packt(ps[2], ps[3]));
                f32x4 pp[4];
#pragma unroll
                for (int nt = 0; nt < 4; ++nt) { pp[nt] = MFMA16H(__builtin_bit_cast(h16x8, nt < 3 ? A1P[nt][0] : *(const LAS v4u*)(park2 + lane * 16)), b0, z4); pp[nt] = MFMA16H(__builtin_bit_cast(h16x8, nt < 3 ? A1P[nt][1] : *(const LAS v4u*)(park2 + 1024 + lane * 16)), b1, pp[nt]); }
                f32x4 qp = MFMA16H(__builtin_bit_cast(h16x8, *(const LAS v4u*)(park + lane * 16)), b0, z4); qp = MFMA16H(__builtin_bit_cast(h16x8, *(const LAS v4u*)(park + 1024 + lane * 16)), b1, qp);
                f32x4 qs; { const v2u kh = *(const LAS v2u*)(sc + SC_KG + (16 * mt + n) * 32 + 8 * q); qs[0] = hlo(kh.x) * rat; qs[1] = hhi(kh.x) * rat; qs[2] = hlo(kh.y) * rat; qs[3] = hhi(kh.y) * rat; }
                qs = MFMA16H(akF, zF[mt], qs);
                wt16(fdst, (mt * 3 + 0) * 1024 + lane * 16, packt(pp[0], pp[1])); wt16(fdst, (mt * 3 + 1) * 1024 + lane * 16, packt(pp[2], pp[3]));
                wt16(fdst, (mt * 3 + 2) * 1024 + lane * 16, packt(qp, qs));
            }
        }
    }
    asm volatile("s_waitcnt lgkmcnt(0)" ::: "memory");
}
constexpr int PRB = 18432, LBB = 24576, NPAIR = CH_SEGCH / 2;
constexpr int ATT_CH = 1;
constexpr int NFB = 8;
constexpr size_t SEG_BYTES = (size_t)NCHAIN * NPAIR * PRB;
DI void chunkB_issue(v4u (&f)[18], v2u& vlo, v2u& vhi, unsigned la, unsigned lv) {
#pragma unroll
    for (int i = 0; i < 18; ++i) asm volatile("ds_read_b128 %0, %1 offset:%2" : "=v"(f[i]) : "v"(la), "n"(i * 1024) : "memory");
    asm volatile("ds_read_b64_tr_b16 %0, %1 offset:18432" : "=v"(vlo) : "v"(lv) : "memory");
    asm volatile("ds_read_b64_tr_b16 %0, %1 offset:20480" : "=v"(vhi) : "v"(lv) : "memory");
}
DI void chunkB_landed(v4u (&f)[18], v2u& vlo, v2u& vhi) {
    asm volatile("s_waitcnt lgkmcnt(0)" : "+v"(f[0]), "+v"(f[1]), "+v"(f[2]), "+v"(f[3]), "+v"(f[4]), "+v"(f[5]), "+v"(f[6]), "+v"(f[7]), "+v"(f[8]), "+v"(f[9]),
                 "+v"(f[10]), "+v"(f[11]), "+v"(f[12]), "+v"(f[13]), "+v"(f[14]), "+v"(f[15]), "+v"(f[16]), "+v"(f[17]), "+v"(vlo), "+v"(vhi) :: "memory");
}
DI void chunkB_pair(const v4u (&f)[18], const v2u& vlo, const v2u& vhi, f32x4 (&Cst)[4], GAS bf16* yp) {
    h16x8 bs0, bs1;
    { v4u p; p.x = pkh2(Cst[0][0], Cst[0][1]); p.y = pkh2(Cst[0][2], Cst[0][3]); p.z = pkh2(Cst[1][0], Cst[1][1]); p.w = pkh2(Cst[1][2], Cst[1][3]); bs0 = __builtin_bit_cast(h16x8, p); }
    { v4u p; p.x = pkh2(Cst[2][0], Cst[2][1]); p.y = pkh2(Cst[2][2], Cst[2][3]); p.z = pkh2(Cst[3][0], Cst[3][1]); p.w = pkh2(Cst[3][2], Cst[3][3]); bs1 = __builtin_bit_cast(h16x8, p); }
    h16x8 bv; { v4u p; p.x = vlo.x; p.y = vlo.y; p.z = vhi.x; p.w = vhi.y; bv = __builtin_bit_cast(h16x8, p); }
    const f32x4 z4 = {0.f, 0.f, 0.f, 0.f};
    f32x4 acc[6];
#pragma unroll
    for (int mt = 0; mt < 6; ++mt) {
        acc[mt] = MFMA16H(__builtin_bit_cast(h16x8, f[mt * 3 + 0]), bs0, z4);
        acc[mt] = MFMA16H(__builtin_bit_cast(h16x8, f[mt * 3 + 1]), bs1, acc[mt]);
        acc[mt] = MFMA16H(__builtin_bit_cast(h16x8, f[mt * 3 + 2]), bv, acc[mt]); }
#pragma unroll
    for (int mt = 0; mt < 4; ++mt) Cst[mt] = acc[mt];
    v2u y1, y2; y1.x = cvt_pk_bf16_c(acc[4][0], acc[4][1]); y1.y = cvt_pk_bf16_c(acc[4][2], acc[4][3]); y2.x = cvt_pk_bf16_c(acc[5][0], acc[5][1]); y2.y = cvt_pk_bf16_c(acc[5][2], acc[5][3]);
    *(GAS v2u*)yp = y1; *(GAS v2u*)(yp + 4 * 64 * 4) = y2;
}
constexpr int SD = 8, NPC = CH_NSEG * NPAIR;
DI void chunkB_chain(const Frame& F, int chain, const unsigned char* sfrag, unsigned char* a2, unsigned* hw, unsigned* bar) {
    const int lane = F.lane;
    LAS unsigned char* lbuf = F.lds;
    if (F.wave < 4) {
        const int vt = F.wave, q = lane >> 4, n = lane & 15;
        GAS bf16* Y = (GAS bf16*)(a2 + A2_Y) + (((size_t)chain * (SEQ / 4) + q) * 64 + 16 * vt + n) * 4;
        f32x4 Cst[4];
#pragma unroll
        for (int i = 0; i < 4; ++i) Cst[i] = (f32x4){0.f, 0.f, 0.f, 0.f};
        const unsigned la0 = (unsigned)(size_t)lbuf + lane * 16, lv0 = (unsigned)(size_t)lbuf + (4 * q + (n >> 2)) * 128 + (16 * vt + 4 * (n & 3)) * 2;
        v4u fA[18], fB[18]; v2u aL, aH, bL, bH;
        __builtin_amdgcn_s_barrier(); asm volatile("" ::: "memory");
        chunkB_issue(fA, aL, aH, la0, lv0);
#pragma unroll 1
        for (int p = 0; p < NPC; p += 2) {
            chunkB_landed(fA, aL, aH);
            __builtin_amdgcn_s_barrier(); asm volatile("" ::: "memory");
            chunkB_issue(fB, bL, bH, la0 + LBB, lv0 + LBB);
            chunkB_pair(fA, aL, aH, Cst, Y + (size_t)p * 2 * 4 * 64 * 4);
            chunkB_landed(fB, bL, bH);
            __builtin_amdgcn_s_barrier(); asm volatile("" ::: "memory");
            if (p + 2 < NPC) chunkB_issue(fA, aL, aH, la0, lv0);
            chunkB_pair(fB, bL, bH, Cst, Y + (size_t)(p + 1) * 2 * 4 * 64 * 4);
            if (((p + 1) & (NPAIR - 1)) == NPAIR - 1 && F.tid == 0) __hip_atomic_store(hw + CW_SDONE + (((p + 1) >> 6) * NCHAIN + chain) * 64, 1u, __ATOMIC_RELAXED, __HIP_MEMORY_SCOPE_AGENT);
        }
    } else {
        const int hwv = F.wave - 4;
        const __amdgpu_buffer_rsrc_t rs = __builtin_amdgcn_make_buffer_rsrc(const_cast<unsigned char*>(sfrag) - WS_SFRAG, 0, (int)WS_END, 0x00020000);
        const int voff = lane * 16;
        LAS unsigned char* ldst = lbuf + hwv * 6 * 1024 + lane * 16;
        v4u r[SD][6];
        auto LD = [&](int Pq, v4u (&rr)[6]) {
            const int P = Pq < NPC ? Pq : NPC - 1, seg = P >> 6;
            if (Pq < NPC && (P & (NPAIR - 1)) == 0) {
                const unsigned* cw = hw + (seg * NCHAIN + chain) * 64; unsigned sp = 0u, v;
                do { asm volatile("global_load_dword %0, %1, off sc1\n\ts_waitcnt vmcnt(0)" : "=v"(v) : "v"(cw) : "memory"); if ((unsigned)__builtin_amdgcn_readfirstlane(v) >= (unsigned)NPAIR) break; __builtin_amdgcn_s_sleep(1); } while (++sp < XB_SPIN_CAP);
                asm volatile("buffer_inv sc1" ::: "memory"); }
            const unsigned fo = (unsigned)WS_SFRAG + (unsigned)(seg % NFB) * (unsigned)SEG_BYTES + (unsigned)(chain * NPAIR + (P & (NPAIR - 1))) * PRB;
            const unsigned vo = (unsigned)(WS_A3 + (size_t)PL_V * PLANE) + (unsigned)(chain * (SEQ / 32) + P) * 4096u;
#pragma unroll
            for (int j = 0; j < 6; ++j) { const int sl = hwv * 6 + j;
                const unsigned so = sl < 18 ? fo + sl * 1024 : vo + (sl < 22 ? sl - 18 : 3) * 1024;
                rr[j] = __builtin_amdgcn_raw_buffer_load_b128(rs, voff, so, 0); }
        };
        auto WR = [&](int P, const v4u (&rr)[6]) {
            if (P < NPC) {
                LAS unsigned char* d = ldst + (P & 1) * LBB;
#pragma unroll
                for (int j = 0; j < 6; ++j) *(LAS v4u*)(d + j * 1024) = rr[j];
            }
        };
#pragma unroll
        for (int k = 0; k < SD; ++k) LD(k, r[k]);
        WR(0, r[0]); LD(SD, r[0]); WR(1, r[1]); LD(SD + 1, r[1]);
        asm volatile("s_waitcnt lgkmcnt(0)" ::: "memory"); __builtin_amdgcn_s_barrier(); asm volatile("" ::: "memory");
#pragma unroll 1
        for (int g = 0; g < NPC; g += SD) {
#pragma unroll
            for (int k = 0; k < SD; ++k) {
                __builtin_amdgcn_s_barrier(); asm volatile("" ::: "memory");
                WR(g + k + 2, r[(k + 2) % SD]); LD(g + k + 2 + SD, r[(k + 2) % SD]);
                asm volatile("s_waitcnt lgkmcnt(0)" ::: "memory");
            }
        }
    }
    asm volatile("s_waitcnt vmcnt(0) lgkmcnt(0)" ::: "memory"); __builtin_amdgcn_s_barrier(); asm volatile("" ::: "memory");
}

#define MFMA32(a, b, c) __builtin_amdgcn_mfma_f32_32x32x16_bf16((a), (b), (c), 0, 0, 0)
DI int crow(int reg, int h) { return (reg & 3) + 8 * (reg >> 2) + 4 * h; }
DI s16x4 tr_read(unsigned lds_addr) { s16x4 r; asm volatile("ds_read_b64_tr_b16 %0, %1\n\ts_waitcnt lgkmcnt(0)" : "=&v"(r) : "v"(lds_addr) : "memory"); return r; }
DI bf16x8 pack_step(const f32x16& x, int s) {
    v4u p;
    asm volatile("s_nop 1\n\tv_cvt_pk_bf16_f32 %0, %4, %5\n\tv_cvt_pk_bf16_f32 %1, %6, %7\n\tv_cvt_pk_bf16_f32 %2, %8, %9\n\tv_cvt_pk_bf16_f32 %3, %10, %11\n\ts_nop 1"
                 : "=&v"(p[0]), "=&v"(p[1]), "=&v"(p[2]), "=&v"(p[3])
                 : "v"(x[8 * s]), "v"(x[8 * s + 1]), "v"(x[8 * s + 2]), "v"(x[8 * s + 3]), "v"(x[8 * s + 4]), "v"(x[8 * s + 5]), "v"(x[8 * s + 6]), "v"(x[8 * s + 7]));
    return __builtin_bit_cast(bf16x8, p);
}
constexpr int VPITCH = 192;
DI void attn_unit(const Frame& F, int unit, unsigned char* a2, const float* sinks) {
    const int lane = F.lane, w = F.wave, r = lane & 31, h = lane >> 5;
    const int b = unit >> 10, kvh = (unit >> 8) & 3, q0 = (unit & 255) * 64;
    const bf16* Q = (const bf16*)(a2 + A2_Q); const bf16* Kp = (const bf16*)(a2 + A2_K); const bf16* Vp = (const bf16*)(a2 + A2_V);
    bf16* O = (bf16*)(a2 + A2_COUT);
    LAS unsigned char* vl = F.lds;
#pragma unroll
    for (int i = 0; i < 3; ++i) { const int c = F.tid + 512 * i, row = c >> 3, pc = c & 7; int kp = q0 - 128 + row; kp = kp < 0 ? 0 : kp;
        const v4u v = *(const GAS v4u*)(Vp + (size_t)(b * SEQ + kp) * 256 + kvh * 64 + pc * 8);
        *(LAS v4u*)(vl + row * VPITCH + pc * 16) = v; }
    const int g = w >> 1, half = w & 1, qh = kvh * 4 + g;
    const int qa = q0 + 32 * half + r;
    bf16x8 qf[4];
#pragma unroll
    for (int s = 0; s < 4; ++s) qf[s] = *(const GAS bf16x8*)(Q + (size_t)(b * SEQ + qa) * C + qh * 64 + 16 * s + 8 * h);
    f32x16 st[5];
    const float sink = sinks[qh];
    float mx = sink;
#pragma unroll
    for (int i = 0; i < 5; ++i) {
        const int kb = q0 - 128 + 32 * (half + i);
        int kr = kb + r; kr = kr < 0 ? 0 : kr;
        bf16x8 kf[4];
#pragma unroll
        for (int s = 0; s < 4; ++s) kf[s] = *(const GAS bf16x8*)(Kp + (size_t)(b * SEQ + kr) * 256 + kvh * 64 + 16 * s + 8 * h);
        f32x16 a;
#pragma unroll
        for (int j = 0; j < 16; ++j) a[j] = 0.f;
#pragma unroll
        for (int s = 0; s < 4; ++s) a = MFMA32(kf[s], qf[s], a);
#pragma unroll
        for (int j = 0; j < 16; ++j) { const int kp = kb + crow(j, h); const bool ok = (kp >= 0) && (kp <= qa) && (kp > qa - 128);
            const float sv = ok ? a[j] * 0.125f : -INFINITY; a[j] = sv; mx = fmaxf(mx, sv); }
        st[i] = a;
    }
    mx = fmaxf(mx, __shfl_xor(mx, 32));
    float l = 0.f;
#pragma unroll
    for (int i = 0; i < 5; ++i)
#pragma unroll
        for (int j = 0; j < 16; ++j) { const float e = __expf(st[i][j] - mx); st[i][j] = e; l += e; }
    l += __shfl_xor(l, 32);
    l += __expf(sink - mx);
    const float inv = 1.0f / l;
    __syncthreads();
    f32x16 ot[2];
#pragma unroll
    for (int db = 0; db < 2; ++db)
#pragma unroll
        for (int j = 0; j < 16; ++j) ot[db][j] = 0.f;
    const unsigned vbase = (unsigned)(size_t)vl;
    const int i16 = lane & 15, q4 = i16 >> 2, p4 = i16 & 3, blk = (lane >> 4) & 1;
#pragma unroll
    for (int i = 0; i < 5; ++i) {
        const int trow = 32 * (half + i);
#pragma unroll
        for (int s = 0; s < 2; ++s) {
            const bf16x8 pb = pack_step(st[i], s);
#pragma unroll
            for (int db = 0; db < 2; ++db) {
                const unsigned cb = (unsigned)((db * 32 + 16 * blk) * 2 + 8 * p4);
                const s16x4 lo = tr_read(vbase + (unsigned)(trow + 16 * s + 4 * h + q4) * VPITCH + cb);
                const s16x4 hi = tr_read(vbase + (unsigned)(trow + 16 * s + 8 + 4 * h + q4) * VPITCH + cb);
                const bf16x8 va = __builtin_shufflevector(lo, hi, 0, 1, 2, 3, 4, 5, 6, 7);
                ot[db] = MFMA32(va, pb, ot[db]);
            }
        }
    }
    bf16* orow = O + (size_t)(b * SEQ + qa) * C + qh * 64;
#pragma unroll
    for (int db = 0; db < 2; ++db)
#pragma unroll
        for (int q = 0; q < 4; ++q) { v2u wv; wv.x = pk2(ot[db][4 * q] * inv, ot[db][4 * q + 1] * inv); wv.y = pk2(ot[db][4 * q + 2] * inv, ot[db][4 * q + 3] * inv);
            *(GAS v2u*)(orow + 32 * db + 8 * q + 4 * h) = wv; }
    __syncthreads();
}

DI void route_tokens(const Frame& F, int layer, const float* logits, const float* bg, const float* be, unsigned* cnt, int* list, float* tg) {
    LAS int* lcnt = (LAS int*)(F.lds);
    LAS int* lbase = lcnt + 32;
#pragma unroll 1
    for (int blk = F.bid; blk < NT / 128; blk += F.G) {
        if (F.tid < 64) lcnt[F.tid] = 0;
        __syncthreads();
        const int tok = blk * 128 + F.tid;
        const bool act = F.tid < 128;
        int e0 = 0, e1 = 0, p0 = 0, p1 = 0; float g0 = 0.f, g1 = 0.f;
        if (act) {
            const float* lg = logits + (size_t)tok * 64;
            float gl[4]; int grp = 0; float gm = -INFINITY;
#pragma unroll
            for (int j = 0; j < 4; ++j) { gl[j] = lg[j] + bg[j]; if (gl[j] > gm) { gm = gl[j]; grp = j; } }
            float gs = 0.f;
#pragma unroll
            for (int j = 0; j < 4; ++j) gs += __expf(gl[j] - gm);
            const float pgrp = 1.0f / gs;
            int i0 = 0; float v0 = -INFINITY; int i1 = 0; float v1 = -INFINITY;
#pragma unroll
            for (int j = 0; j < 8; ++j) { const float el = lg[4 + grp * 8 + j] + be[grp * 8 + j];
                if (el > v0) { v1 = v0; i1 = i0; v0 = el; i0 = j; } else if (el > v1) { v1 = el; i1 = j; } }
            const float x1 = __expf(v1 - v0);
            g0 = pgrp / (1.0f + x1); g1 = pgrp * x1 / (1.0f + x1);
            e0 = grp * 8 + i0; e1 = grp * 8 + i1;
            p0 = atomicAdd((int*)&lcnt[e0], 1); p1 = atomicAdd((int*)&lcnt[e1], 1);
        }
        __syncthreads();
        if (F.tid < 32) { const int c = lcnt[F.tid]; lbase[F.tid] = c ? (int)atomicAdd(cnt + layer * 32 + F.tid, (unsigned)c) : 0; }
        __syncthreads();
        if (act) {
            list[(size_t)e0 * NT + lbase[e0] + p0] = tok * 2; list[(size_t)e1 * NT + lbase[e1] + p1] = tok * 2 + 1;
            tg[2 * tok] = g0; tg[2 * tok + 1] = g1;
        }
        __syncthreads();
    }
}
DI int moe_tables(const Frame& F, int layer, const unsigned* cnt, const int* list, int ncol, bool down, LAS int* rb2e, LAS int* rows) {
    LAS int* scnt = rb2e + 320; LAS int* sstart = scnt + 32;
    if (F.tid < NEXP) scnt[F.tid] = (int)__hip_atomic_load((unsigned*)cnt + layer * 32 + F.tid, RLX_AGENT);
    __syncthreads();
    if (F.tid == 0) { int acc = 0;
#pragma unroll 1
        for (int e = 0; e < NEXP; ++e) { const int c = scnt[e]; sstart[e] = acc; const int nb = (c + 255) >> 8;
#pragma unroll 1
            for (int j = 0; j < nb; ++j) rb2e[acc + j] = e;
            acc += nb; } sstart[NEXP] = acc; }
    __syncthreads();
    const int RB = __builtin_amdgcn_readfirstlane(sstart[NEXP]), total = RB * ncol;
#pragma unroll 1
    for (int ui = 0; ; ++ui) {
        const long L = (long)ui * F.G + F.bid; if (L >= total) break;
        const int rb = (int)(L / ncol), e = rb2e[rb], lb = rb - sstart[e];
        if (F.tid < 256) { const int idx = lb * 256 + F.tid; int v;
            if (idx < scnt[e]) { const int ent = list[(size_t)e * NT + idx]; v = down ? ent : (ent >> 1); } else v = down ? -1 : 0;
            rows[ui * 256 + F.tid] = v; }
    }
    __syncthreads();
    return RB;
}

DI const void* in_ptr(const Args& args, int idx) { asm volatile("" : "+s"(idx)); return args.in[idx]; }
template <int PLO, int PHI> __global__ void __launch_bounds__(NWAVES * 64, 2) mega_fwd(Args args) {
    extern __shared__ __attribute__((aligned(16))) unsigned char lds_raw[];
    Frame F0;
    F0.lds = (LAS unsigned char*)lds_raw; F0.ws = args.ws;
    F0.tid = threadIdx.x; F0.lane = F0.tid & 63; F0.wave = __builtin_amdgcn_readfirstlane(F0.tid >> 6);
    F0.G = gridDim.x; F0.bid = blockIdx.x; F0.gw = F0.bid * NWAVES + F0.wave; F0.NGW = F0.G * NWAVES;
    float* out = args.out;
    volatile LAS unsigned* MISC = (volatile LAS unsigned*)(F0.lds + MISC_OFF);
    if (F0.tid < 32) MISC[F0.tid] = 0u;
    __syncthreads();
#if MK_ONE_LAUNCH
    XcdBarrier bar = xcd_barrier_post((unsigned*)(args.ws + WS_CTL) + CW_BAR, MISC + 8);
#define GRID_BAR() xcd_barrier(bar)
#else
#define GRID_BAR() do {} while (0)
#endif
#define IN(k) (PLO <= (k) && (k) < PHI)
#define PHASE_BEGIN() Frame F = F0; { int t_ = F0.tid; asm volatile("" : "+v"(t_)); F.tid = t_; F.lane = t_ & 63; F.wave = __builtin_amdgcn_readfirstlane(t_ >> 6); F.gw = F.bid * NWAVES + F.wave; int g_ = F0.G; asm volatile("" : "+s"(g_)); F.G = g_; F.NGW = g_ * NWAVES; } \
        unsigned char* ws = F0.ws; asm volatile("" : "+s"(ws)); LAS unsigned char* ring = F.lds; \
        unsigned char* a2 = ws + WS_A2; unsigned char* a3 = ws + WS_A3; unsigned char* a4 = ws + WS_A4; unsigned char* wl = ws + WS_W; bf16* Hb = (bf16*)(ws + WS_H); unsigned* ctl = (unsigned*)(ws + WS_CTL); \
        bf16* WinT = (bf16*)(wl + W_WIN); bf16* WloraT = (bf16*)(wl + W_LORA); bf16* WpoolT = (bf16*)(wl + W_POOL); bf16* WbT = (bf16*)(wl + W_BR); bf16* WoT = (bf16*)(wl + W_WO); bf16* WrT = (bf16*)(wl + W_RT); \
        float* logits = (float*)(ws + WS_LOG); int* list = (int*)(ws + WS_LIST); float* tg = (float*)(ws + WS_TG); \
        bf16* Y2 = (bf16*)(a2 + A2_Y2); bf16* HM = (bf16*)(a2 + A2_HM); bf16* W13T = (bf16*)(a3 + A3_W13); bf16* W2T = (bf16*)(a3 + A3_W2); bf16* merged = (bf16*)a4; \
        (void)a2; (void)a3; (void)a4; (void)Hb; (void)ctl; (void)WinT; (void)WloraT; (void)WpoolT; (void)WbT; (void)WoT; (void)WrT; (void)logits; (void)list; (void)tg; (void)Y2; (void)HM; (void)W13T; (void)W2T; (void)merged; (void)ring
#define INP(idx, stride) ((const float*)in_ptr(args, idx) + (size_t)layer * (stride))

#pragma unroll 1
    for (int layer = args.l_lo; layer < args.l_hi; ++layer) {
        if constexpr (IN(0)) {
            PHASE_BEGIN();
            const float* x_in = INP(I_X, 0); const float* attn_norm = INP(I_ATTN_NORM, D); const float* w_in = INP(I_WIN, (size_t)D * INC);
            const float* w_up = INP(I_WUP, 96 * C); const float* a_up = INP(I_AUP, 96 * C); const float* g_up = INP(I_GUP, 256 * C);
            const float* pool_w = INP(I_POOLW, 4 * 256 * 256); const float* pool_s = INP(I_POOLS, C);
            const float* w_br = INP(I_WBR, (size_t)3 * C * D); const float* w_out = INP(I_WOUT, (size_t)D * D);
            const float* rgw = INP(I_RGW, D * 4); const float* rew = INP(I_REW, D * 32);
            constexpr int I_IN = 32 * 382, I_BR = 3 * 16 * 64, I_WO = 32 * 64;
            auto p0_item = [&](int r, const float*& W, int& K, int& N, bf16*& WT, int& drow, int& k0, int& n0) {
                if (r < I_IN) { const int kb = r / 382, nb = r % 382; n0 = 32 * nb; W = w_in; K = D; N = INC; WT = WinT; drow = n0 + (n0 >= ZC ? 64 : 0); k0 = 64 * kb; return; } r -= I_IN;
                if (r < I_BR) { const int br = r / 1024, q = r % 1024, kb = q / 64, nb = q % 64; W = w_br + (size_t)br * C * D; K = C; N = D; WT = WbT + (size_t)br * D * C; drow = 32 * nb; k0 = 64 * kb; n0 = 32 * nb; return; } r -= I_BR;
                { const int kb = r / 64, nb = r % 64; W = w_out; K = D; N = D; WT = WoT; drow = 32 * nb; k0 = 64 * kb; n0 = 32 * nb; }
            };
#pragma unroll 1
            for (int it = F.gw; it < I_IN + I_BR + I_WO; it += 2 * F.NGW) {
                const int it1 = it + F.NGW; const bool has1 = it1 < I_IN + I_BR + I_WO;
                const float* Wa; const float* Wb2; bf16* Ta; bf16* Tb; int Ka, Na, da, ka, na, Kb, Nb, db, kb2, nb2;
                p0_item(it, Wa, Ka, Na, Ta, da, ka, na); p0_item(has1 ? it1 : it, Wb2, Kb, Nb, Tb, db, kb2, nb2);
                f32x4 va[8], vb[8];
                tr_load(va, Wa, Na, ka, na, F.lane); tr_load(vb, Wb2, Nb, kb2, nb2, F.lane);
                tr_store(va, Ta, Ka, da, ka, F.lane);
                if (has1) tr_store(vb, Tb, Kb, db, kb2, F.lane);
            }
            const int gt = F.bid * 512 + F.tid, NGT = F.G * 512;
            for (int i = gt; i < 64 * 2048 / 8; i += NGT) *(GAS v4u*)(WinT + (size_t)ZC * D + (size_t)i * 8) = (v4u){0u, 0u, 0u, 0u};
            for (int i = gt; i < 3 * 1024 * 256; i += NGT) { const int m = i >> 18, n = (i >> 8) & 1023, k = i & 255; float v = 0.f;
                if (m == 0) { if (k < 96) v = w_up[(size_t)k * C + n]; } else if (m == 1) { if (k < 96) v = a_up[(size_t)k * C + n]; } else v = g_up[(size_t)k * C + n];
                WloraT[i] = (bf16)f2bf(v); }
            for (int i = gt; i < 4 * 256 * 256; i += NGT) { const int g = i >> 16, n = (i >> 8) & 255, k = i & 255; WpoolT[i] = (bf16)f2bf(pool_w[(size_t)g * 65536 + (size_t)k * 256 + n] * pool_s[g * 256 + n]); }
            for (int i = gt; i < 256 * 2048; i += NGT) { const int n = i >> 11, k = i & 2047; float v = 0.f; if (n < 4) v = rgw[(size_t)k * 4 + n]; else if (n < 36) v = rew[(size_t)k * 32 + (n - 4)]; WrT[i] = (bf16)f2bf(v); }
            {
                const bool comb = layer > 0; const float* xsrc = comb ? out : x_in;
                if (!comb) {
#pragma unroll 1
                    for (int m = F.gw; m < NT; m += 2 * F.NGW) {
                        const int m1 = m + F.NGW; const bool has1 = m1 < NT;
                        f32x4 va[8], vb[8];
                        const GAS f32x4* xa = (const GAS f32x4*)(xsrc + (size_t)m * D) + F.lane; const GAS f32x4* xb = (const GAS f32x4*)(xsrc + (size_t)(has1 ? m1 : m) * D) + F.lane;
#pragma unroll
                        for (int j = 0; j < 8; ++j) { va[j] = xa[64 * j]; vb[j] = xb[64 * j]; }
                        rms_store(va, attn_norm, Hb + (size_t)m * D, F.lane);
                        if (has1) rms_store(vb, attn_norm, Hb + (size_t)m1 * D, F.lane);
                    }
                } else {
#pragma unroll 1
                    for (int m = F.gw; m < NT; m += F.NGW) {
                        f32x4 v[8];
                        const GAS f32x4* xr = (const GAS f32x4*)(out + (size_t)m * D) + F.lane;
#pragma unroll
                        for (int j = 0; j < 8; ++j) v[j] = xr[64 * j];
                        moe_combine(v, Y2, tg, m, F.lane);
                        GAS f32x4* xo = (GAS f32x4*)(out + (size_t)m * D) + F.lane;
#pragma unroll
                        for (int j = 0; j < 8; ++j) xo[64 * j] = v[j];
                        rms_store(v, attn_norm, Hb + (size_t)m * D, F.lane);
                    }
                }
            }
            GRID_BAR();
        }
        if constexpr (IN(1)) for (int rep_ = 0; rep_ < PROBE_REPS(1); ++rep_) {
            PHASE_BEGIN();
            DenseSched S{(const char*)Hb, (const char*)WinT, (size_t)256 * D * 2, (size_t)256 * D * 2, 128, 24, F.G, F.bid};
            EpiProj E{a2};
            pg::gemm_phase<EpiProj, DenseSched, false>(ring, D * 2, D * 2, D, S, E);
            GRID_BAR();
        }
        if constexpr (IN(2)) {
            PHASE_BEGIN();
            const float* mu = INP(I_MU, ZC); const float* k_k = INP(I_KK, C); const float* qn = INP(I_QN, HD); const float* kn = INP(I_KN, HD); const int* positions = (const int*)in_ptr(args, I_POS);
#pragma unroll 1
            for (int m = F.gw; m < NT / 16; m += F.NGW) prep_block(F, m, a2, a3, a4, mu, k_k, qn, kn, positions);
            GRID_BAR();
        }
        if constexpr (IN(3)) for (int rep_ = 0; rep_ < PROBE_REPS(3); ++rep_) {
            { PHASE_BEGIN(); LoraSched S{(const char*)(a4 + A4_LORA), (const char*)WloraT, F.G, F.bid}; EpiLora E{a2, a3};
              pg::gemm_phase<EpiLora, LoraSched, false>(ring, 1024 * 2, 256 * 2, 256, S, E); }
            { PHASE_BEGIN(); PoolSched S{(const char*)(a4 + A4_POOL), (const char*)WpoolT, F.G, F.bid}; EpiPool E{(bf16*)(a2 + A2_BOUT)};
              pg::gemm_phase<EpiPool, PoolSched, false>(ring, 1024 * 2, 256 * 2, 256, S, E); }
            GRID_BAR();
        }
        if constexpr (IN(5)) for (int rep_ = 0; rep_ < PROBE_REPS(5); ++rep_) {
            {
                {   PHASE_BEGIN();
                    const bool chainwg = F.bid < NCHAIN;
                    unsigned char* fb = ws + WS_SFRAG;
                    LAS unsigned char* sc = ring + F.wave * SC_BYTES;
                    LAS unsigned char* park = F.lds + TBL_OFF + F.wave * 4096;
                    LAS unsigned char* park2 = park + 2048;
                    const float* pw0 = INP(I_W0, C); const float* pa0 = INP(I_A0, C); const float* pk_a = INP(I_KA, C); const float* pr_k = INP(I_RK, C); float* bonus = (float*)(ws + WS_BON);
                    unsigned* hw = ctl + CW_SCAN + (size_t)(layer * 2 + rep_) * (CH_NSEG * NCHAIN * 64);
                    unsigned* bar = ctl + CW_BAR;
                    const int nw = chainwg ? CH_NSEG * NCHAIN * NPAIR : (F.G - NCHAIN) * NWAVES;
                    const float* sinks = INP(I_SINK, NH);
                    const bool attfirst = !chainwg && ((F.bid >> 3) & 1);
                    int au = chainwg ? 2048 : ATT_CH * NCHAIN + F.bid - NCHAIN;
#pragma unroll 1
                    for (int u0 = chainwg ? F.bid * NWAVES : NCHAIN * NWAVES + (F.bid - NCHAIN) * NWAVES; u0 < CH_NSEG * NCHAIN * NPAIR || au < 2048; u0 += nw) {
                        const int u = u0 + F.wave;
#pragma unroll 1
                        for (int st = 0; st < 2; ++st) {
                        if ((st == 0) != attfirst) {
                        if (u < CH_NSEG * NCHAIN * NPAIR) {
                        const int seg = u / (NCHAIN * NPAIR), r = u % (NCHAIN * NPAIR), chain = r >> 6, pl = r & (NPAIR - 1);
                        if (seg >= NFB) XB_SPIN(xb_ld(hw + CW_SDONE + ((seg - NFB) * NCHAIN + chain) * 64) == 0u, bar);
                        const __amdgpu_buffer_rsrc_t blk = __builtin_amdgcn_make_buffer_rsrc(fb + (size_t)(seg % NFB) * SEG_BYTES + (size_t)r * PRB, 0, PRB, 0x00020000);
#pragma unroll 1
                        for (int rp_ = 0; rp_ < PROBE_REPS(21); ++rp_) {
                        v4u A1P[3][2];
                        chunkA_unit<0>(F.lane, chain, seg * CH_SEGCH + 2 * pl, a3, blk, sc, pw0, pa0, pk_a, pr_k, bonus, A1P, park, park2);
                        chunkA_unit<1>(F.lane, chain, seg * CH_SEGCH + 2 * pl + 1, a3, blk, sc, pw0, pa0, pk_a, pr_k, bonus, A1P, park, park2); }
                        asm volatile("s_waitcnt vmcnt(0)" ::: "memory");
                        if (F.lane == 0) (void)xb_add(hw + (seg * NCHAIN + chain) * 64, 1u);
                        }
                        __syncthreads();
                        } else
                        if (au < 2048) {
                            Frame FA = F; { int t_ = F.tid; asm volatile("" : "+v"(t_)); FA.tid = t_; FA.lane = t_ & 63; FA.wave = __builtin_amdgcn_readfirstlane(t_ >> 6); }
                            unsigned char* a2q = a2; const float* snk = sinks; asm volatile("" : "+s"(a2q), "+s"(snk));
                            attn_unit(FA, au, a2q, snk); au += F.G - NCHAIN; __syncthreads(); }
                        }
                    }
                    if (F.tid < 32) ((volatile LAS unsigned*)(F.lds + MISC_OFF))[F.tid] = 0u;
                    __syncthreads();
                }
            }
            if (F0.bid < NCHAIN) {
                PHASE_BEGIN();
                unsigned* hw = ctl + CW_SCAN + (size_t)(layer * 2 + rep_) * (CH_NSEG * NCHAIN * 64);
                chunkB_chain(F, F.bid, ws + WS_SFRAG, a2, hw, ctl + CW_BAR);
            }
            {
                PHASE_BEGIN();
                const float* sinks = INP(I_SINK, NH);
                if (F.bid < NCHAIN) {
#pragma unroll 1
                    for (int u = F.bid; u < ATT_CH * NCHAIN; u += NCHAIN) attn_unit(F, u, a2, sinks);
                }
            }
            GRID_BAR();
        }
        if constexpr (IN(6)) for (int rep_ = 0; rep_ < PROBE_REPS(6); ++rep_) {
            PHASE_BEGIN();
            const float* ln_g = INP(I_LNG, C); const float* ln_b = INP(I_LNB, C);
            postscan_phase(F, a2, a3, ln_g, ln_b, (const float*)(ws + WS_BON));
            GRID_BAR();
        }
        if constexpr (IN(7)) for (int rep_ = 0; rep_ < PROBE_REPS(7); ++rep_) {
            PHASE_BEGIN();
            DenseSched S{(const char*)Hb, (const char*)(WinT + (size_t)NPROJ * D), (size_t)256 * D * 2, (size_t)256 * D * 2, 128, 24, F.G, F.bid};
            EpiGates E{(bf16*)a3};
            pg::gemm_phase<EpiGates, DenseSched, false>(ring, D * 2, D * 2, D, S, E);
            GRID_BAR();
        }
        if constexpr (IN(8)) for (int rep_ = 0; rep_ < PROBE_REPS(8); ++rep_) {
            PHASE_BEGIN();
            BranchSched S{(const char*)a2, (const char*)WbT, F.G, F.bid};
            EpiBranch E{(const bf16*)a3, merged};
            pg::gemm_phase<EpiBranch, BranchSched, false>(ring, C * 2, C * 2, C, S, E);
            GRID_BAR();
        }
        if constexpr (IN(9)) {
#pragma unroll 1
            for (int step = 0; step < 2; ++step) {
            if ((step == 0) != (((F0.bid >> 3) & 1) != 0)) { PHASE_BEGIN();
              const float* x_in = INP(I_X, 0);
              DenseSched S{(const char*)merged, (const char*)WoT, (size_t)256 * D * 2, (size_t)256 * D * 2, 128, 8, F.G, F.bid};
              EpiResid E{layer == 0 ? x_in : out, out};
              pg::gemm_phase<EpiResid, DenseSched, false>(ring, D * 2, D * 2, D, S, E); }
            else { PHASE_BEGIN();
              const float* ew1 = INP(I_W1, (size_t)NEXP * D * FF); const float* ew3 = INP(I_W3, (size_t)NEXP * D * FF); const float* ew2 = INP(I_W2, (size_t)NEXP * FF * D);
              expert_items(ew1, ew3, ew2, W13T, W2T, EXP_P11, 2 * 16384, F.gw, F.NGW, F.lane); }
            }
            GRID_BAR();
        }
        if constexpr (IN(10)) for (int rep_ = 0; rep_ < PROBE_REPS(10); ++rep_) {
            PHASE_BEGIN();
            const float* ffn_norm = INP(I_FFN_NORM, D);
            {
#pragma unroll 1
                for (int m = F.gw; m < NT; m += 2 * F.NGW) {
                    const int m1 = m + F.NGW; const bool has1 = m1 < NT;
                    f32x4 va[8], vb[8];
                    const GAS f32x4* xa = (const GAS f32x4*)(out + (size_t)m * D) + F.lane; const GAS f32x4* xb = (const GAS f32x4*)(out + (size_t)(has1 ? m1 : m) * D) + F.lane;
#pragma unroll
                    for (int j = 0; j < 8; ++j) { va[j] = xa[64 * j]; vb[j] = xb[64 * j]; }
                    rms_store(va, ffn_norm, Hb + (size_t)m * D, F.lane);
                    if (has1) rms_store(vb, ffn_norm, Hb + (size_t)m1 * D, F.lane);
                }
            }
            GRID_BAR();
        }
        if constexpr (IN(11)) for (int rep_ = 0; rep_ < PROBE_REPS(11); ++rep_) {
            PHASE_BEGIN();
            DenseSched S{(const char*)Hb, (const char*)WrT, (size_t)256 * D * 2, (size_t)256 * D * 2, 128, 1, F.G, F.bid};
            EpiRouter E{logits};
            pg::gemm_phase<EpiRouter, DenseSched, false>(ring, D * 2, D * 2, D, S, E);
            if (F.G > 128 && F.bid >= 128) {
                const float* ew1 = INP(I_W1, (size_t)NEXP * D * FF); const float* ew3 = INP(I_W3, (size_t)NEXP * D * FF); const float* ew2 = INP(I_W2, (size_t)NEXP * FF * D);
                expert_items(ew1, ew3, ew2, W13T, W2T, 0, EXP_P11, (F.bid - 128) * NWAVES + F.wave, (F.G - 128) * NWAVES, F.lane); }
            else if (F.G <= 128) { const float* ew1 = INP(I_W1, (size_t)NEXP * D * FF); const float* ew3 = INP(I_W3, (size_t)NEXP * D * FF); const float* ew2 = INP(I_W2, (size_t)NEXP * FF * D);
                expert_items(ew1, ew3, ew2, W13T, W2T, 0, EXP_P11, F.gw, F.NGW, F.lane); }
            GRID_BAR();
        }
        if constexpr (IN(12)) {
            PHASE_BEGIN();
            const float* rgb = INP(I_RGB, 4); const float* reb = INP(I_REB, 32);
            route_tokens(F, layer, logits, rgb, reb, ctl + CW_CNT, list, tg);
            GRID_BAR();
        }
        if constexpr (IN(13)) for (int rep_ = 0; rep_ < PROBE_REPS(13); ++rep_) {
            PHASE_BEGIN();
            LAS int* rb2e = (LAS int*)(F.lds + TBL_OFF); LAS int* rows = rb2e + 512;
            const int RB = moe_tables(F, layer, ctl + CW_CNT, list, 4, false, rb2e, rows);
            typedef MoeSched<4, (size_t)1024 * D * 2, (size_t)256 * D * 2, 0> SchedUp; SchedUp S{(const char*)Hb, (const char*)W13T, RB * 4, F.G, F.bid, rb2e, rows};
            EpiMoeUp E{HM};
            pg::gemm_phase<EpiMoeUp, SchedUp, true>(ring, D * 2, D * 2, D, S, E);
            { const int extra = (RB * 4) % F.G;
              if (F.bid >= extra) { const float* ew1 = INP(I_W1, (size_t)NEXP * D * FF); const float* ew3 = INP(I_W3, (size_t)NEXP * D * FF); const float* ew2 = INP(I_W2, (size_t)NEXP * FF * D);
                expert_items(ew1, ew3, ew2, W13T, W2T, 2 * 16384, 3 * 16384, (F.bid - extra) * NWAVES + F.wave, (F.G - extra) * NWAVES, F.lane); } }
            GRID_BAR();
        }
        if constexpr (IN(14)) for (int rep_ = 0; rep_ < PROBE_REPS(14); ++rep_) {
            PHASE_BEGIN();
            LAS int* rb2e = (LAS int*)(F.lds + TBL_OFF); LAS int* rows = rb2e + 512;
            const int RB = moe_tables(F, layer, ctl + CW_CNT, list, 8, true, rb2e, rows);
            typedef MoeSched<8, (size_t)D * FF * 2, (size_t)256 * FF * 2, (size_t)256 * FF * 2> SchedDn; SchedDn S{(const char*)HM, (const char*)W2T, RB * 8, F.G, F.bid, rb2e, rows};
            EpiMoeDown E{Y2, rows};
            pg::gemm_phase<EpiMoeDown, SchedDn, false>(ring, FF * 2, FF * 2, FF, S, E);
            GRID_BAR();
        }
        if constexpr (IN(15)) if (layer == DEPTH - 1) {
            PHASE_BEGIN();
            {
#pragma unroll 1
                for (int m = F.gw; m < NT; m += F.NGW) {
                    f32x4 v[8]; GAS f32x4* xr = (GAS f32x4*)(out + (size_t)m * D) + F.lane;
#pragma unroll
                    for (int j = 0; j < 8; ++j) v[j] = xr[64 * j];
                    moe_combine(v, Y2, tg, m, F.lane);
#pragma unroll
                    for (int j = 0; j < 8; ++j) xr[64 * j] = v[j];
                }
            }
        }
    }
#undef IN
}

template <int P> static void launch_phase(int grid, hipStream_t stream, Args a) { hipLaunchKernelGGL((mega_fwd<P, P + 1>), dim3(grid), dim3(NWAVES * 64), LDS_BYTES, stream, a); }
template <int P> static bool set_attr() { return hipFuncSetAttribute((const void*)mega_fwd<P, P + 1>, hipFuncAttributeMaxDynamicSharedMemorySize, LDS_BYTES) == hipSuccess; }
extern "C" void kernel_launch(void* const* d_in, const int* in_sizes, int n_in, void* d_out, int out_size, void* d_ws, size_t ws_size, hipStream_t stream) {
    static int grid = 0;
    if (grid == 0) {
        if (n_in != 30 || out_size != NT * D || ws_size < WS_END) { fprintf(stderr, "kernel_launch: unexpected problem (n_in %d, out %d, ws %zu < %zu)\n", n_in, out_size, ws_size, (size_t)WS_END); grid = -1; return; }
        int dev = 0, cus = 0;
        if (hipGetDevice(&dev) != hipSuccess || hipDeviceGetAttribute(&cus, hipDeviceAttributeMultiprocessorCount, dev) != hipSuccess) { grid = -1; return; }
#if MK_ONE_LAUNCH
        bool ok = hipFuncSetAttribute((const void*)mega_fwd<0, NPH + 1>, hipFuncAttributeMaxDynamicSharedMemorySize, LDS_BYTES) == hipSuccess;
#else
        bool ok = set_attr<0>() && set_attr<1>() && set_attr<2>() && set_attr<3>() && set_attr<4>() && set_attr<5>() && set_attr<6>() && set_attr<7>() && set_attr<8>() && set_attr<9>() && set_attr<10>() && set_attr<11>() && set_attr<12>() && set_attr<13>() && set_attr<14>() && set_attr<15>();
#endif
        if (!ok) { fprintf(stderr, "kernel_launch: hipFuncSetAttribute failed\n"); grid = -1; return; }
        (void)hipGetLastError();
        grid = cus;
    }
    if (grid < 0) return;
    if (hipMemsetAsync((char*)d_ws + WS_CTL, 0, CTL_BYTES, stream) != hipSuccess) return;
    Args a{};
    for (int i = 0; i < 30; ++i) a.in[i] = d_in[i];
    a.out = (float*)d_out; a.ws = (unsigned char*)d_ws;
#if MK_ONE_LAUNCH
    a.l_lo = 0; a.l_hi = DEPTH; a.ph_lo = 0; a.ph_hi = NPH + 1;
    hipLaunchKernelGGL((mega_fwd<0, NPH + 1>), dim3(grid), dim3(NWAVES * 64), LDS_BYTES, stream, a);
#else
    for (int l = 0; l < DEPTH; ++l) {
        a.l_lo = l; a.l_hi = l + 1; a.ph_lo = 0; a.ph_hi = 0;
        launch_phase<0>(grid, stream, a); launch_phase<1>(grid, stream, a); launch_phase<2>(grid, stream, a); launch_phase<3>(grid, stream, a); launch_phase<4>(grid, stream, a);
        launch_phase<5>(grid, stream, a); launch_phase<6>(grid, stream, a); launch_phase<7>(grid, stream, a); launch_phase<8>(grid, stream, a); launch_phase<9>(grid, stream, a);
        launch_phase<10>(grid, stream, a); launch_phase<11>(grid, stream, a); launch_phase<12>(grid, stream, a); launch_phase<13>(grid, stream, a); launch_phase<14>(grid, stream, a);
        if (l == DEPTH - 1) launch_phase<15>(grid, stream, a);
    }
#endif
}
```
